# Optimizing an MI355X kernel written in HIP

```python
import jax, jax.numpy as jnp
from jax import lax
import numpy as np

D_MODEL = 1024
BATCH = 4
SEQ = 8192
DEPTH = 1

CHUNK = 64
PLE_DIM = 256
HG_HEADS = 4
HG_DK = 128
HG_DV = (D_MODEL // 2) // HG_HEADS
HG_WIDTH = HG_HEADS * HG_DV
ML_HEADS = 4
ML_DV = (D_MODEL // 2) // ML_HEADS
ML_DQK = ML_DV // 2
ML_WIDTH = ML_HEADS * ML_DV
MIX_WIDTH = HG_WIDTH + ML_WIDTH
CONV_K = 4
D_FF = ((8 * D_MODEL + 3 * 256 - 1) // (3 * 256)) * 256
ALPHA = float((2 * DEPTH) ** 0.25)
BETA = float((8 * DEPTH) ** -0.25)
LN_EPS = 1e-5
RMS_EPS = 1e-6
ML_I_BIAS = -2.0
ML_F_BIAS_LO = 3.0
ML_F_BIAS_HI = 6.0
PROJ_SIZES = (
    HG_HEADS * HG_DK,
    HG_HEADS * HG_DK,
    HG_WIDTH,
    HG_WIDTH,
    ML_HEADS * ML_DQK,
    ML_HEADS * ML_DQK,
    ML_WIDTH,
    ML_WIDTH,
    ML_HEADS,
    ML_HEADS,
)
PROJ_WIDTH = sum(PROJ_SIZES)

kernel_name = "hymba_hgrn2_mlstm_deepnorm_block"


def _split_cols(u):
    idx, acc = [], 0
    for s in PROJ_SIZES[:-1]:
        acc += s
        idx.append(acc)
    return jnp.split(u, idx, axis=-1)


def layer_norm(x, g, b):
    xf = x.astype(jnp.float32)
    mu = jnp.mean(xf, -1, keepdims=True)
    var = jnp.mean(jnp.square(xf - mu), -1, keepdims=True)
    return ((xf - mu) * lax.rsqrt(var + LN_EPS)).astype(x.dtype) * g + b


def head_rms_norm(h, g):
    hf = h.astype(jnp.float32)
    hf = hf * lax.rsqrt(jnp.mean(hf * hf, -1, keepdims=True) + RMS_EPS)
    B, S, H, Dh = h.shape
    return hf.reshape(B, S, H * Dh).astype(g.dtype) * g


def causal_conv(x, w, b):
    S = x.shape[1]
    xp = jnp.pad(x, ((0, 0), (CONV_K - 1, 0), (0, 0)))
    out = xp[:, 0:S] * w[0]
    for k in range(1, CONV_K):
        out = out + xp[:, k:k + S] * w[k]
    return out + b


def to_chunks(t):
    B, S, H, D = t.shape
    return t.reshape(B, S // CHUNK, CHUNK, H, D).transpose(1, 0, 3, 2, 4)


def gate_chunks(t):
    B, S, H = t.shape
    return t.reshape(B, S // CHUNK, CHUNK, H).transpose(1, 0, 3, 2)


def from_chunks(t):
    N, B, H, C, D = t.shape
    return t.transpose(1, 0, 3, 2, 4).reshape(B, N * C, H, D)


def hgrn2_mixer(q, log_f, k, v):
    B, S, H, DK = q.shape
    DV = v.shape[-1]
    mask = jnp.tril(jnp.ones((CHUNK, CHUNK), dtype=bool))[:, :, None]

    def step(state, inp):
        q_, g_, k_, v_ = inp
        b = jnp.cumsum(g_, axis=2)
        diff = b[:, :, :, None, :] - b[:, :, None, :, :]
        decay = jnp.exp(jnp.where(mask, diff, -jnp.inf))
        scores = jnp.einsum('bhtd,bhsd,bhtsd->bhts', q_, k_, decay)
        o_intra = jnp.einsum('bhts,bhsv->bhtv', scores, v_)
        o_inter = jnp.einsum('bhtd,bhdv->bhtv', q_ * jnp.exp(b), state)
        b_last = b[:, :, -1:, :]
        k_dec = k_ * jnp.exp(b_last - b)
        new_state = jnp.exp(b_last[:, :, 0, :])[..., None] * state + jnp.einsum('bhsd,bhsv->bhdv', k_dec, v_)
        return new_state, o_intra + o_inter

    state0 = jnp.zeros((B, H, DK, DV), jnp.float32)
    _, o = lax.scan(step, state0, (to_chunks(q), to_chunks(log_f), to_chunks(k), to_chunks(v)))
    return from_chunks(o).astype(v.dtype)


def mlstm_mixer(q, k, v, i_pre, log_f):
    B, S, H, DQK = q.shape
    DV = v.shape[-1]
    q = q * (DQK ** -0.5)
    mask = jnp.tril(jnp.ones((CHUNK, CHUNK), dtype=bool))

    def step(carry, inp):
        C_st, n_st, m_st = carry
        q_, k_, v_, ig, lf = inp
        g = jnp.cumsum(lf, axis=-1)
        dmat = g[..., :, None] - g[..., None, :] + ig[..., None, :]
        dmat = jnp.where(mask, dmat, -jnp.inf)
        m_inter = g + m_st[..., None]
        m_t = jnp.maximum(m_inter, jnp.max(dmat, -1))
        w_intra = jnp.exp(dmat - m_t[..., None])
        w_inter = jnp.exp(m_inter - m_t)
        qk = jnp.einsum('bhtd,bhsd->bhts', q_, k_) * w_intra
        num = jnp.einsum('bhts,bhsv->bhtv', qk, v_) + w_inter[..., None] * jnp.einsum('bhtd,bhdv->bhtv', q_, C_st)
        den = jnp.sum(qk, -1) + w_inter * jnp.einsum('bhtd,bhd->bht', q_, n_st)
        h = num / jnp.maximum(jnp.abs(den), jnp.exp(-m_t))[..., None]
        g_last = g[..., -1]
        a = g_last[..., None] - g + ig
        m_new = jnp.maximum(g_last + m_st, jnp.max(a, -1))
        ws = jnp.exp(a - m_new[..., None])
        w_old = jnp.exp(g_last + m_st - m_new)
        C_new = w_old[..., None, None] * C_st + jnp.einsum('bhs,bhsd,bhsv->bhdv', ws, k_, v_)
        n_new = w_old[..., None] * n_st + jnp.einsum('bhs,bhsd->bhd', ws, k_)
        return (C_new, n_new, m_new), h

    carry0 = (jnp.zeros((B, H, DQK, DV), jnp.float32),
              jnp.zeros((B, H, DQK), jnp.float32),
              jnp.zeros((B, H), jnp.float32))
    _, h = lax.scan(step, carry0, (to_chunks(q), to_chunks(k), to_chunks(v),
                                   gate_chunks(i_pre), gate_chunks(log_f)))
    return from_chunks(h).astype(v.dtype)


def setup_inputs(seed: int = 0) -> dict:
    key = jax.random.key(seed)
    ks = jax.random.split(key, 20)
    f32 = jnp.float32
    nrm = lambda k, shape, scale: jax.random.normal(k, shape, f32) * scale
    x = nrm(ks[0], (BATCH, SEQ, D_MODEL), 1.0)
    p = nrm(ks[1], (DEPTH, BATCH, SEQ, PLE_DIM), 1.0)
    w_in = nrm(ks[2], (DEPTH, D_MODEL, PROJ_WIDTH), D_MODEL ** -0.5)
    b_in = nrm(ks[3], (DEPTH, PROJ_WIDTH), 0.02)
    ig_off = PROJ_WIDTH - 2 * ML_HEADS
    fg_off = PROJ_WIDTH - ML_HEADS
    b_in = b_in.at[:, ig_off:fg_off].add(ML_I_BIAS)
    b_in = b_in.at[:, fg_off:].add(jnp.linspace(ML_F_BIAS_LO, ML_F_BIAS_HI, ML_HEADS, dtype=f32))
    hg_lb_logits = nrm(ks[4], (DEPTH + 1, HG_HEADS * HG_DK), 0.5)
    ml_conv_w = nrm(ks[5], (DEPTH, CONV_K, 2 * ML_HEADS * ML_DQK), CONV_K ** -0.5)
    ml_conv_b = nrm(ks[6], (DEPTH, 2 * ML_HEADS * ML_DQK), 0.02)
    hg_norm_g = 1.0 + nrm(ks[7], (DEPTH, HG_WIDTH), 0.02)
    ml_norm_g = 1.0 + nrm(ks[8], (DEPTH, ML_WIDTH), 0.02)
    w_out = nrm(ks[9], (DEPTH, MIX_WIDTH, D_MODEL), BETA * MIX_WIDTH ** -0.5)
    ln1_g = 1.0 + nrm(ks[10], (DEPTH, D_MODEL), 0.02)
    ln1_b = nrm(ks[11], (DEPTH, D_MODEL), 0.02)
    w_ffn_gate = nrm(ks[12], (DEPTH, D_MODEL, D_FF), D_MODEL ** -0.5)
    w_ffn_up = nrm(ks[13], (DEPTH, D_MODEL, D_FF), D_MODEL ** -0.5)
    w_ffn_down = nrm(ks[14], (DEPTH, D_FF, D_MODEL), BETA * D_FF ** -0.5)
    ln2_g = 1.0 + nrm(ks[15], (DEPTH, D_MODEL), 0.02)
    ln2_b = nrm(ks[16], (DEPTH, D_MODEL), 0.02)
    ple_w_proj = nrm(ks[17], (DEPTH, PLE_DIM, D_MODEL), PLE_DIM ** -0.5)
    ple_w_gate = nrm(ks[18], (DEPTH, D_MODEL, D_MODEL), D_MODEL ** -0.5)
    ple_b_gate = nrm(ks[19], (DEPTH, D_MODEL), 0.02)
    return {"x": x, "p": p, "w_in": w_in, "b_in": b_in, "hg_lb_logits": hg_lb_logits,
            "ml_conv_w": ml_conv_w, "ml_conv_b": ml_conv_b, "hg_norm_g": hg_norm_g,
            "ml_norm_g": ml_norm_g, "w_out": w_out, "ln1_g": ln1_g, "ln1_b": ln1_b,
            "w_ffn_gate": w_ffn_gate, "w_ffn_up": w_ffn_up, "w_ffn_down": w_ffn_down,
            "ln2_g": ln2_g, "ln2_b": ln2_b, "ple_w_proj": ple_w_proj,
            "ple_w_gate": ple_w_gate, "ple_b_gate": ple_b_gate}


def reference(x, p, w_in, b_in, hg_lb_logits, ml_conv_w, ml_conv_b, hg_norm_g, ml_norm_g,
              w_out, ln1_g, ln1_b, w_ffn_gate, w_ffn_up, w_ffn_down, ln2_g, ln2_b,
              ple_w_proj, ple_w_gate, ple_b_gate):
    B, S, _ = x.shape
    lower_bounds = jnp.cumsum(jax.nn.softmax(hg_lb_logits.astype(jnp.float32), axis=0), axis=0)
    for i in range(DEPTH):
        u = x @ w_in[i] + b_in[i]
        hq, hf, hv, hgate, mq, mk, mv, mo, mig, mfg = _split_cols(u)

        lb = lower_bounds[i]
        log_f = jnp.logaddexp(jnp.log(lb), jnp.log1p(-lb) + jax.nn.log_sigmoid(hf.astype(jnp.float32)))
        k_hg = -jnp.expm1(log_f)
        o_hg = hgrn2_mixer(jax.nn.silu(hq).reshape(B, S, HG_HEADS, HG_DK),
                           log_f.reshape(B, S, HG_HEADS, HG_DK),
                           k_hg.reshape(B, S, HG_HEADS, HG_DK),
                           hv.reshape(B, S, HG_HEADS, HG_DV))
        o_hg = head_rms_norm(o_hg, hg_norm_g[i]) * jax.nn.silu(hgate)

        qk_c = jax.nn.silu(causal_conv(jnp.concatenate([mq, mk], -1), ml_conv_w[i], ml_conv_b[i]))
        mq_c, mk_c = jnp.split(qk_c, 2, axis=-1)
        h_ml = mlstm_mixer(mq_c.reshape(B, S, ML_HEADS, ML_DQK),
                           mk_c.reshape(B, S, ML_HEADS, ML_DQK),
                           mv.reshape(B, S, ML_HEADS, ML_DV),
                           mig.astype(jnp.float32),
                           jax.nn.log_sigmoid(mfg.astype(jnp.float32)))
        o_ml = head_rms_norm(h_ml, ml_norm_g[i]) * jax.nn.sigmoid(mo)

        mix = jnp.concatenate([o_hg, o_ml], -1) @ w_out[i]
        x = layer_norm(ALPHA * x + mix, ln1_g[i], ln1_b[i])

        ffn = (jax.nn.silu(x @ w_ffn_gate[i]) * (x @ w_ffn_up[i])) @ w_ffn_down[i]
        x = layer_norm(ALPHA * x + ffn, ln2_g[i], ln2_b[i])

        x = x + jax.nn.sigmoid(x @ ple_w_gate[i] + ple_b_gate[i]) * (p[i] @ ple_w_proj[i])
    return x
```

```cpp
#include <hip/hip_runtime.h>
#include <cstdio>
#include <cstdint>


#ifndef MK_N_LAUNCHES
#define MK_N_LAUNCHES 1
#endif

namespace pg8 {
#define PG8_LAS __attribute__((address_space(3)))
typedef unsigned short bf16_t;
typedef short bf16x8 __attribute__((ext_vector_type(8)));
typedef float f32x4 __attribute__((ext_vector_type(4)));
typedef float f32x2 __attribute__((ext_vector_type(2)));
typedef unsigned u32x4 __attribute__((ext_vector_type(4)));
typedef unsigned u32x2 __attribute__((ext_vector_type(2)));
constexpr int BM = 256, BK = 64, HALF = 128, HTB = HALF * BK * 2, STAGE_BYTES = 8 * HTB, NXCD = 8, WGM = 8;

__host__ __device__ __forceinline__ int lds_byte(int r, int c) { const int st = (r >> 4) * 2 + (c >> 5), rr = r & 15, cc = c & 31, ob = rr * 64 + cc * 2; return st * 1024 + (ob ^ (((ob >> 9) & 1) << 5)); }
__host__ __device__ __forceinline__ void stage_rc(int b, int& R, int& C) { const int st = b / 1024, sb = b % 1024, swz = sb ^ (((sb >> 9) & 1) << 5); R = (st >> 1) * 16 + swz / 64; C = (st & 1) * 32 + (swz % 64) / 2; }
__host__ __device__ __forceinline__ int perm32(int rho) { const int n = rho >> 4, i = rho & 15; return 8 * (i >> 2) + 4 * n + (i & 3); }

struct Unit { int pm, pn; };
struct Gemm { const bf16_t* A; const bf16_t* Bt; int M, N, K; };

struct StaticOrder {
    int nM, nN, nwg, G, c;
    __host__ __device__ void init(int M, int N, int G_, int c_) { nM = M / BM; nN = N / BM; nwg = nM * nN; G = G_; c = c_; }
    __host__ __device__ bool next(int i, Unit& u) const {
        const long L = (long)i * G + c; if (L >= nwg) return false;
        int wgid = (int)L; { const int q = nwg / NXCD, r = nwg % NXCD, xcd = wgid % NXCD, off = wgid / NXCD; wgid = (xcd < r ? xcd * (q + 1) : r * (q + 1) + (xcd - r) * q) + off; }
        const int nig = WGM * nN, gid = wgid / nig, fm = gid * WGM, gsz = (nM - fm) < WGM ? (nM - fm) : WGM;
        u.pm = fm + ((wgid % nig) % gsz); u.pn = (wgid % nig) / gsz; return true;
    }
    __device__ __forceinline__ void a_ready(const Unit&) const {}
    __device__ __forceinline__ void done(const Unit&) const {}
};

typedef __bf16 bf16v2_t __attribute__((ext_vector_type(2)));
__device__ __forceinline__ unsigned cvt_pk_bf16(float lo, float hi) { const f32x2 v = {lo, hi}; return __builtin_bit_cast(unsigned, __builtin_convertvector(v, bf16v2_t)); }

template <class Epi, class Sched, bool ALIGN_EPI = false, bool SP2 = false>
__device__ __forceinline__ void gemm_phase(PG8_LAS unsigned char* lds, const Gemm g, const Sched& S, const Epi& E) {
    const int tid = threadIdx.x, wid = __builtin_amdgcn_readfirstlane(tid >> 6), lane = tid & 63, wr = wid >> 2, wc = wid & 3, fr = lane & 15, fq = lane >> 4;
    const int K = g.K, nt = K / BK;
    unsigned voffA[2], voffB[2];
#pragma unroll
    for (int i = 0; i < 2; ++i) { int R, C; stage_rc(tid * 16 + i * 8192, R, C); const int Rb = Epi::PERM ? ((R & ~31) + perm32(R & 31)) : R;
        voffA[i] = (unsigned)(R * K + C) * 2u; voffB[i] = (unsigned)(Rb * K + C) * 2u; }
    const size_t kstep = (size_t)(BK * 2);
    const size_t hstep = (size_t)HALF * K * 2;
    const size_t tstep = 2 * hstep;
    const unsigned ldsw = (unsigned)wid * 1024u;
    const int aoff = lds_byte(wr * 64 + fr, fq * 8), boff = lds_byte(wc * 32 + fr, fq * 8);
#define PG8_SA(b, h) (((b) * 2 + (h)) * HTB)
#define PG8_SB(b, h) ((4 + (b) * 2 + (h)) * HTB)
#define PG8_STAGE(bufoff, gbase, voff) do { _Pragma("unroll") for (int _i = 0; _i < 2; ++_i) \
        __builtin_amdgcn_global_load_lds((const unsigned*)((const char*)(gbase) + (voff)[_i]), (PG8_LAS unsigned*)(lds + (bufoff) + ldsw + _i * 8192), 16, 0, 0); } while (0)
#define PG8_LDA(dst, b, h) do { _Pragma("unroll") for (int m = 0; m < 4; ++m) _Pragma("unroll") for (int k = 0; k < 2; ++k) dst[m][k] = *(const PG8_LAS bf16x8*)(lds + PG8_SA(b, h) + aoff + m * 2048 + k * 1024); } while (0)
#define PG8_LDB(dst, b, h) do { _Pragma("unroll") for (int n = 0; n < 2; ++n) _Pragma("unroll") for (int k = 0; k < 2; ++k) dst[n][k] = *(const PG8_LAS bf16x8*)(lds + PG8_SB(b, h) + boff + n * 2048 + k * 1024); } while (0)
#define PG8_MMA(ai, bj, At, Bt) do { __builtin_amdgcn_s_setprio(1); _Pragma("unroll") for (int m = 0; m < 4; ++m) _Pragma("unroll") for (int n = 0; n < 2; ++n) _Pragma("unroll") for (int k = 0; k < 2; ++k) \
        acc[ai][bj][m][n] = __builtin_amdgcn_mfma_f32_16x16x32_bf16(Bt[n][k], At[m][k], acc[ai][bj][m][n], 0, 0, 0); __builtin_amdgcn_s_setprio(0); } while (0)
#define PG8_WAIT_V(n) asm volatile("s_waitcnt vmcnt(" #n ")" ::: "memory")
#define PG8_WAIT_L(n) asm volatile("s_waitcnt lgkmcnt(" #n ")" ::: "memory")
#define PG8_BAR __builtin_amdgcn_s_barrier()
#define PG8_SCHED __builtin_amdgcn_sched_barrier(0)
    Unit cur, nxt; int ui = 0;
    if (!S.next(0, cur)) return;
    f32x4 acc[2][2][4][2];
#pragma unroll
    for (int a = 0; a < 2; ++a)
#pragma unroll
        for (int b = 0; b < 2; ++b)
#pragma unroll
            for (int m = 0; m < 4; ++m)
#pragma unroll
                for (int n = 0; n < 2; ++n) acc[a][b][m][n] = (f32x4){0.f, 0.f, 0.f, 0.f};
    bf16x8 At[4][2], B0[2][2], B1[2][2];
    const char* cA = (const char*)g.A + (size_t)cur.pm * tstep; const char* cB = (const char*)g.Bt + (size_t)cur.pn * tstep;
    S.a_ready(cur);
    if constexpr (SP2) {
        PG8_STAGE(PG8_SB(0, 0), cB, voffB); PG8_STAGE(PG8_SB(0, 1), cB + hstep, voffB); PG8_STAGE(PG8_SA(0, 0), cA, voffA); PG8_STAGE(PG8_SA(0, 1), cA + hstep, voffA);
        if (wr == 1) PG8_BAR;
        PG8_WAIT_V(2); PG8_BAR;
        PG8_STAGE(PG8_SB(1, 0), cB + kstep, voffB); PG8_STAGE(PG8_SA(1, 0), cA + kstep, voffA); PG8_STAGE(PG8_SB(1, 1), cB + hstep + kstep, voffB);
        PG8_WAIT_V(6); PG8_BAR;
    } else {
        PG8_STAGE(PG8_SB(0, 0), cB, voffB); PG8_STAGE(PG8_SA(0, 0), cA, voffA); PG8_STAGE(PG8_SB(0, 1), cB + hstep, voffB); PG8_STAGE(PG8_SA(0, 1), cA + hstep, voffA);
        if (wr == 1) PG8_BAR;
        PG8_WAIT_V(4); PG8_BAR;
        PG8_STAGE(PG8_SB(1, 0), cB + kstep, voffB); PG8_STAGE(PG8_SA(1, 0), cA + kstep, voffA); PG8_STAGE(PG8_SB(1, 1), cB + hstep + kstep, voffB);
        PG8_WAIT_V(6); PG8_BAR;
    }
    for (;;) {
        const bool has_next = S.next(ui + 1, nxt);
        const char* nA = has_next ? (const char*)g.A + (size_t)nxt.pm * tstep : cA; const char* nB = has_next ? (const char*)g.Bt + (size_t)nxt.pn * tstep : cB;
        for (int t = 0; t < nt; t += 2) {
            const bool last = (t == nt - 2);
            const char* a1 = cA + (size_t)(t + 1) * kstep;
            const char* a2 = last ? nA : cA + (size_t)(t + 2) * kstep; const char* b2 = last ? nB : cB + (size_t)(t + 2) * kstep;
            const char* a3 = a2 + kstep; const char* b3 = b2 + kstep;
            if (last && has_next) S.a_ready(nxt);
            if constexpr (SP2) {
            PG8_LDB(B0, 0, 0); PG8_LDB(B1, 0, 1); PG8_SCHED; PG8_LDA(At, 0, 0); PG8_STAGE(PG8_SA(1, 1), a1 + hstep, voffA);
            PG8_WAIT_V(8); PG8_WAIT_L(0); PG8_BAR; PG8_MMA(0, 0, At, B0); PG8_MMA(0, 1, At, B1); PG8_BAR; PG8_SCHED;
            PG8_LDA(At, 0, 1); PG8_STAGE(PG8_SB(0, 0), b2, voffB); PG8_STAGE(PG8_SB(0, 1), b2 + hstep, voffB); PG8_STAGE(PG8_SA(0, 0), a2, voffA);
            PG8_WAIT_V(8); PG8_WAIT_L(0); PG8_BAR; PG8_MMA(1, 0, At, B0); PG8_MMA(1, 1, At, B1); PG8_BAR; PG8_SCHED;
            PG8_LDB(B0, 1, 0); PG8_LDB(B1, 1, 1); PG8_SCHED; PG8_LDA(At, 1, 0); PG8_STAGE(PG8_SA(0, 1), a2 + hstep, voffA);
            PG8_WAIT_V(8); PG8_WAIT_L(0); PG8_BAR; PG8_MMA(0, 0, At, B0); PG8_MMA(0, 1, At, B1); PG8_BAR; PG8_SCHED;
            PG8_LDA(At, 1, 1); PG8_STAGE(PG8_SB(1, 0), b3, voffB); PG8_STAGE(PG8_SB(1, 1), b3 + hstep, voffB); PG8_STAGE(PG8_SA(1, 0), a3, voffA);
            PG8_WAIT_V(8); PG8_WAIT_L(0); PG8_BAR; PG8_MMA(1, 0, At, B0); PG8_MMA(1, 1, At, B1); PG8_BAR; PG8_SCHED;
            } else {
            PG8_LDB(B0, 0, 0); PG8_SCHED; PG8_LDA(At, 0, 0); PG8_STAGE(PG8_SA(1, 1), a1 + hstep, voffA);
            PG8_WAIT_L(8); PG8_BAR; PG8_WAIT_L(0); PG8_MMA(0, 0, At, B0); PG8_BAR; PG8_SCHED;
            PG8_LDB(B1, 0, 1); PG8_STAGE(PG8_SB(0, 0), b2, voffB);
            PG8_BAR; PG8_WAIT_L(0); PG8_MMA(0, 1, At, B1); PG8_BAR;
            PG8_LDA(At, 0, 1); PG8_STAGE(PG8_SA(0, 0), a2, voffA);
            PG8_BAR; PG8_WAIT_L(0); PG8_MMA(1, 0, At, B0); PG8_BAR; PG8_SCHED;
            PG8_STAGE(PG8_SB(0, 1), b2 + hstep, voffB);
            PG8_WAIT_V(6); PG8_BAR; PG8_MMA(1, 1, At, B1); PG8_BAR;
            PG8_LDB(B0, 1, 0); PG8_SCHED; PG8_LDA(At, 1, 0); PG8_STAGE(PG8_SA(0, 1), a2 + hstep, voffA);
            PG8_WAIT_L(8); PG8_BAR; PG8_WAIT_L(0); PG8_MMA(0, 0, At, B0); PG8_BAR; PG8_SCHED;
            PG8_LDB(B1, 1, 1); PG8_STAGE(PG8_SB(1, 0), b3, voffB);
            PG8_BAR; PG8_WAIT_L(0); PG8_MMA(0, 1, At, B1); PG8_BAR;
            PG8_LDA(At, 1, 1); PG8_STAGE(PG8_SA(1, 0), a3, voffA);
            PG8_BAR; PG8_WAIT_L(0); PG8_MMA(1, 0, At, B0); PG8_BAR; PG8_SCHED;
            PG8_STAGE(PG8_SB(1, 1), b3 + hstep, voffB);
            PG8_WAIT_V(6); PG8_BAR; PG8_MMA(1, 1, At, B1); PG8_BAR;
            }
        }
        if constexpr (ALIGN_EPI) { if (wr == 0) PG8_BAR; }
        E(acc, cur, wr, wc, fr, fq); S.done(cur);
        if (!has_next) break;
#pragma unroll
        for (int a = 0; a < 2; ++a)
#pragma unroll
            for (int b = 0; b < 2; ++b)
#pragma unroll
                for (int m = 0; m < 4; ++m)
#pragma unroll
                    for (int n = 0; n < 2; ++n) acc[a][b][m][n] = (f32x4){0.f, 0.f, 0.f, 0.f};
        cur = nxt; cA = nA; cB = nB; ++ui;
        if constexpr (ALIGN_EPI) { if (wr == 1) PG8_BAR; }
    }
    PG8_WAIT_V(0);
    if constexpr (!ALIGN_EPI) { if (wr == 0) PG8_BAR; }
    PG8_BAR;
#undef PG8_SA
#undef PG8_SB
#undef PG8_STAGE
#undef PG8_LDA
#undef PG8_LDB
#undef PG8_MMA
#undef PG8_WAIT_V
#undef PG8_WAIT_L
#undef PG8_BAR
#undef PG8_SCHED
}
}

#ifndef PG8_SP2
#define PG8_SP2 true
#endif
#ifndef PG8_ALIGN
#define PG8_ALIGN true
#endif

constexpr int NWAVES = 8;
constexpr int NPHASE = 9;
constexpr int N_LAUNCHES = MK_N_LAUNCHES;
constexpr int BATCH = 4, SEQ = 8192, D = 1024, M = BATCH * SEQ, PLE = 256, FF = 2816;
constexpr int PROJW = 3592, NIN = 3584;
constexpr int NGU = 2 * FF;
constexpr size_t MiB0 = 1u << 20;
constexpr float ALPHA = 1.189207115002721f;
constexpr float LN_EPS = 1e-5f, RMS_EPS = 1e-6f;
constexpr size_t UO_Q = 0, UO_K = 32 * MiB0, UO_V = 64 * MiB0, UO_G = 96 * MiB0, UO_MQ = 128 * MiB0, UO_MK = 144 * MiB0, UO_MV = 160 * MiB0, UO_MO = 192 * MiB0;
constexpr int C_HQ = 0, C_HF = 512, C_HV = 1024, C_HG = 1536, C_MQ = 2048, C_MK = 2304, C_MV = 2560, C_MO = 3072;

constexpr size_t MiB = 1u << 20;
constexpr size_t WS_CTL = 0, CTL_ZERO_BYTES = 1 * MiB;
constexpr int CW_BAR = 4096;
constexpr size_t CTL_CS_GU = 64 * 1024, CTL_BW_GU = CTL_CS_GU + NGU * 4, CTL_CS_PG = CTL_BW_GU + NGU * 4, CTL_BW_PG = CTL_CS_PG + D * 4;
static_assert(CTL_BW_PG + D * 4 <= 128 * 1024, "ctl vectors");
constexpr size_t CTL_ST1 = 256 * 1024, CTL_ST2 = 512 * 1024;
static_assert(CTL_ST2 + (size_t)M * 8 <= CTL_ZERO_BYTES, "ctl stats");
constexpr size_t WS_OML = 1 * MiB;
constexpr size_t WS_WIN = 2 * MiB;
constexpr size_t WS_WOUT = 9 * MiB;
constexpr size_t WS_WGU = 11 * MiB;
constexpr size_t WS_WDN = 22 * MiB;
constexpr size_t WS_WPG = 28 * MiB;
constexpr size_t WS_WPP = 30 * MiB;
constexpr size_t WS_GATES = 31 * MiB;
constexpr size_t WS_XB = 32 * MiB;
constexpr size_t WS_PB = 96 * MiB;
constexpr size_t WS_U = 112 * MiB;
constexpr size_t WS_LOGF = 336 * MiB;
constexpr size_t WS_ER = 400 * MiB;
constexpr size_t WS_EL = 401 * MiB;
constexpr size_t WS_ASC = 402 * MiB;
constexpr size_t WS_MLS = 403 * MiB;
constexpr size_t WS_MLN = 404 * MiB;
constexpr size_t WS_HGS = 408 * MiB;
constexpr size_t WS_MLC = 440 * MiB;
constexpr size_t WS_HGI = 456 * MiB;
constexpr size_t WS_MLCI = 488 * MiB;
constexpr size_t WS_MLNI = 504 * MiB;
constexpr size_t WS_MLI = 505 * MiB;
constexpr size_t WS_END = 506 * MiB;

constexpr int RING_OFF = 0, RING_BYTES = 131072;
constexpr int LDS_BYTES = 163840;
constexpr int LDSCTL_OFF = LDS_BYTES - 1024, MISC_OFF = LDSCTL_OFF + 320;

#define GAS __attribute__((address_space(1)))
#define LAS __attribute__((address_space(3)))
typedef unsigned short bf16;
typedef unsigned v4u __attribute__((ext_vector_type(4)));
typedef unsigned v2u __attribute__((ext_vector_type(2)));
typedef float f32x4 __attribute__((ext_vector_type(4)));
typedef float f32x2 __attribute__((ext_vector_type(2)));
typedef GAS unsigned gu32;
#define RLX_AGENT __ATOMIC_RELAXED, __HIP_MEMORY_SCOPE_AGENT
#define LDS_WAIT() asm volatile("s_waitcnt lgkmcnt(0)" ::: "memory")
#define VM_WAIT() asm volatile("s_waitcnt vmcnt(0)" ::: "memory")
__device__ __forceinline__ unsigned f2bf(float f) { unsigned u = __builtin_bit_cast(unsigned, f); return (u + 0x7fffu + ((u >> 16) & 1u)) >> 16; }
__device__ __forceinline__ unsigned pk2(float lo, float hi) { return f2bf(lo) | (f2bf(hi) << 16); }
__device__ __forceinline__ float bf2f(unsigned short b) { return __builtin_bit_cast(float, (unsigned)b << 16); }
__device__ __forceinline__ float bflo(unsigned w) { return __builtin_bit_cast(float, w << 16); }
__device__ __forceinline__ float bfhi(unsigned w) { return __builtin_bit_cast(float, w & 0xffff0000u); }
__device__ __forceinline__ float fsigmoid(float x) { return __builtin_amdgcn_rcpf(1.0f + __expf(-x)); }
__device__ __forceinline__ float fsilu(float x) { return x * fsigmoid(x); }
__device__ __forceinline__ float wave_sum(float v) {
#pragma unroll
    for (int o = 1; o < 64; o <<= 1) v += __shfl_xor(v, o);
    return v;
}

#define XB_TMO      128
#define XB_XCNT(j)  (256  + 64 * (j))
#define XB_XSUB(j)  (1280 + 64 * (j))
#define XB_XGEN(j)  (2304 + 64 * (j))
#define XB_TOP      3328
#define XB_TOPGEN   3392
#define XCD_BAR_WORDS 3456
#define XB_SPIN_CAP (1u << 22)
__device__ __forceinline__ unsigned xb_ld(unsigned* p)              { return __hip_atomic_load(p, __ATOMIC_RELAXED, __HIP_MEMORY_SCOPE_AGENT); }
__device__ __forceinline__ unsigned xb_add(unsigned* p, unsigned v) { return __hip_atomic_fetch_add(p, v, __ATOMIC_RELAXED, __HIP_MEMORY_SCOPE_AGENT); }
__device__ __forceinline__ unsigned xb_xcc_id() { return (unsigned)__builtin_amdgcn_s_getreg((3 << 11) | 20) & 0xFu; }
#define XB_SPIN(cond, bar) do { unsigned _sp = 0; while (cond) { __builtin_amdgcn_s_sleep(1); \
    if ((++_sp & 255u) == 0u) { if (xb_ld(&(bar)[XB_TMO])) break; if (_sp > XB_SPIN_CAP) { atomicAdd(&(bar)[XB_TMO], 1u); break; } } } } while (0)
struct XcdBarrier { unsigned* bar; unsigned x; volatile LAS unsigned* st; };
__device__ __forceinline__ XcdBarrier xcd_barrier_post(unsigned* bar, volatile LAS unsigned* st) {
    XcdBarrier b; b.bar = bar; b.x = xb_xcc_id(); b.st = st;
    if (threadIdx.x == 0) (void)xb_add(&bar[XB_XCNT(b.x)], 1u);
    return b;
}
__device__ __forceinline__ void xcd_barrier_complete(unsigned* bar, unsigned x, unsigned& nloc, unsigned& nx) {
    const unsigned G = gridDim.x * gridDim.y * gridDim.z;
    unsigned sum, cnt, mine, sp = 0u;
    for (;;) {
        sum = 0u; cnt = 0u; mine = 0u;
#pragma unroll
        for (unsigned j = 0; j < 16; ++j) { const unsigned c = xb_ld(&bar[XB_XCNT(j)]); sum += c; cnt += (c > 0u) ? 1u : 0u; mine = (j == x) ? c : mine; }
        if (sum == G) break;
        __builtin_amdgcn_s_sleep(1);
        if ((++sp & 255u) == 0u) { if (xb_ld(&bar[XB_TMO])) break; if (sp > XB_SPIN_CAP) { atomicAdd(&bar[XB_TMO], 1u); break; } }
    }
    nloc = mine > 0u ? mine : 1u; nx = cnt > 0u ? cnt : 1u;
}
__device__ __forceinline__ void xcd_barrier(const XcdBarrier& b) {
    asm volatile("s_waitcnt vmcnt(0)" ::: "memory");
    __syncthreads();
    if (threadIdx.x == 0) {
        unsigned* bar = b.bar;
        __builtin_amdgcn_s_waitcnt(0);
        unsigned nloc = b.st[0], nx = b.st[1];
        if (nloc == 0u) { xcd_barrier_complete(bar, b.x, nloc, nx); b.st[0] = nloc; b.st[1] = nx; }
        const unsigned old = xb_add(&bar[XB_XSUB(b.x)], 1u);
        const unsigned gen = old / nloc;
        if (old + 1u == (gen + 1u) * nloc) {
            __builtin_amdgcn_fence(__ATOMIC_RELEASE, "agent");
            asm volatile("s_waitcnt vmcnt(0)" ::: "memory");
            const unsigned og = xb_add(&bar[XB_TOP], 1u);
            const unsigned tg = og / nx;
            if (og + 1u == (tg + 1u) * nx) xb_add(&bar[XB_TOPGEN], 1u);
            else XB_SPIN(xb_ld(&bar[XB_TOPGEN]) == tg, bar);
            __builtin_amdgcn_fence(__ATOMIC_ACQUIRE, "agent");
            xb_add(&bar[XB_XGEN(b.x)], 1u);
            asm volatile("s_waitcnt vmcnt(0)" ::: "memory");
        } else {
            XB_SPIN(xb_ld(&bar[XB_XGEN(b.x)]) == gen, bar);
            __builtin_amdgcn_fence(__ATOMIC_ACQUIRE, "agent");
            asm volatile("s_waitcnt vmcnt(0)" ::: "memory");
        }
    }
    __syncthreads();
}

using pg8::Unit; using pg8::cvt_pk_bf16; using pg8::HALF; using pg8::BM;
#define HF_DPP(x, ctrl) __builtin_bit_cast(float, __builtin_amdgcn_update_dpp(0, __builtin_bit_cast(int, (x)), (ctrl), 0xF, 0xF, true))
struct EpiInProj {
    static constexpr bool PERM = true;
    bf16* U; bf16* EQ; float* ER; float* EL; const float* bias; const float* oml;
    __device__ __forceinline__ void operator()(const f32x4 (&acc)[2][2][4][2], const Unit& u, int wr, int wc, int fr, int fq) const {
        const int row0 = u.pm * BM + wr * 64 + fr, col0 = u.pn * BM + wc * 32 + 8 * fq;
        const int pn = u.pn;
        const int type = (pn < 2) ? 1 : (pn < 4) ? 3 : (pn < 6) ? 0 : (pn < 8) ? 1 : (pn < 12) ? 0 : 2;
        if (type != 3) {
            f32x4 bv[2][2];
#pragma unroll
            for (int bj = 0; bj < 2; ++bj)
#pragma unroll
                for (int n = 0; n < 2; ++n) bv[bj][n] = *(const f32x4*)(bias + col0 + bj * HALF + 4 * n);
            const size_t tbase = (pn < 2) ? UO_Q : (pn < 6) ? UO_V : (pn < 8) ? UO_G : (pn == 8) ? UO_MQ : (pn == 9) ? UO_MK : (pn < 12) ? UO_MV : UO_MO;
            const bool narrow = (pn == 8) || (pn == 9);
            const int hpair = narrow ? 0 : 2 * (pn & 1);
            bf16* dst[2];
#pragma unroll
            for (int bj = 0; bj < 2; ++bj) { const int head = narrow ? (2 * bj + (wc >> 1)) : (hpair + bj); const int colh = narrow ? ((wc & 1) * 32 + 8 * fq) : (wc * 32 + 8 * fq);
                dst[bj] = (bf16*)((char*)U + tbase) + (size_t)head * M * (narrow ? 64 : 128) + colh; }
            const int W = narrow ? 64 : 128;
#pragma unroll
            for (int ai = 0; ai < 2; ++ai)
#pragma unroll
                for (int m = 0; m < 4; ++m) { const size_t row = (size_t)(row0 + ai * HALF + m * 16);
#pragma unroll
                    for (int bj = 0; bj < 2; ++bj) { f32x4 v0 = acc[ai][bj][m][0] + bv[bj][0], v1 = acc[ai][bj][m][1] + bv[bj][1];
                        if (type == 1) {
#pragma unroll
                            for (int j = 0; j < 4; ++j) { v0[j] = fsilu(v0[j]); v1[j] = fsilu(v1[j]); }
                        } else if (type == 2) {
#pragma unroll
                            for (int j = 0; j < 4; ++j) { v0[j] = fsigmoid(v0[j]); v1[j] = fsigmoid(v1[j]); }
                        }
                        pg8::u32x4 w; w.x = cvt_pk_bf16(v0[0], v0[1]); w.y = cvt_pk_bf16(v0[2], v0[3]); w.z = cvt_pk_bf16(v1[0], v1[1]); w.w = cvt_pk_bf16(v1[2], v1[3]);
                        *(pg8::u32x4*)(dst[bj] + row * W) = w; } }
        } else {
            const int cb = col0 - C_HF;
#pragma unroll
            for (int ai = 0; ai < 2; ++ai) { const int cidx = u.pm * 4 + ai * 2 + wr;
#pragma unroll
                for (int bj = 0; bj < 2; ++bj)
#pragma unroll
                    for (int n = 0; n < 2; ++n) { const size_t hoff = ((size_t)(2 * (pn - 2) + bj) * M + (size_t)(row0 + ai * HALF)) * 128 + wc * 32 + 8 * fq + 4 * n;
                        hf_block(acc[ai][bj][0][n], acc[ai][bj][1][n], acc[ai][bj][2][n], acc[ai][bj][3][n], cb + bj * HALF + 4 * n, EQ + hoff, (bf16*)((char*)U + UO_K) + hoff, cidx, fr); } }
        }
    }
    static __device__ __forceinline__ float hf_total(float scanv) {
        float o = scanv - HF_DPP(scanv, 0x111);
        o += HF_DPP(o, 0x128); o += HF_DPP(o, 0x124); o += HF_DPP(o, 0x122); o += HF_DPP(o, 0x121); return o; }
    __device__ __forceinline__ void hf_block(const f32x4& a0, const f32x4& a1, const f32x4& a2, const f32x4& a3, int c, bf16* eqp, bf16* ukp, int cidx, int fr) const {
        const f32x4 bv = *(const f32x4*)(bias + C_HF + c), ov = *(const f32x4*)(oml + c);
        f32x4 k0, k1, k2, k3, l0, l1, l2, l3;
#define HF_SCAN { x += HF_DPP(x, 0x111); x += HF_DPP(x, 0x112); x += HF_DPP(x, 0x114); x += HF_DPP(x, 0x118); }
#define HF_BC(v) hf_total(v)
#define HF_ONE(A, KK, LL) _Pragma("unroll") for (int j = 0; j < 4; ++j) { const float k = ov[j] * fsigmoid(-(A[j] + bv[j])); KK[j] = k; float x = __logf(1.0f - k); \
            HF_SCAN LL[j] = x; }
        HF_ONE(a0, k0, l0) __builtin_amdgcn_sched_barrier(0); HF_ONE(a1, k1, l1) __builtin_amdgcn_sched_barrier(0); HF_ONE(a2, k2, l2) __builtin_amdgcn_sched_barrier(0); HF_ONE(a3, k3, l3) __builtin_amdgcn_sched_barrier(0);
#undef HF_ONE
        f32x4 t0, t1, t2, t3;
#pragma unroll
        for (int j = 0; j < 4; ++j) { t0[j] = HF_BC(l0[j]); t1[j] = HF_BC(l1[j]); t2[j] = HF_BC(l2[j]); t3[j] = HF_BC(l3[j]); }
        const f32x4 r = t0 + t1, bl = r + t2 + t3;
        const f32x4 b0 = l0, b1 = l1 + t0, b2 = l2 + r, b3 = l3 + r + t2;
#define HF_ST(B, KK, M) { f32x4 e, kt; _Pragma("unroll") for (int j = 0; j < 4; ++j) { e[j] = __expf(B[j] - r[j]); kt[j] = KK[j] * __expf(r[j] - B[j]); } \
            pg8::u32x2 we, wk; we.x = cvt_pk_bf16(e[0], e[1]); we.y = cvt_pk_bf16(e[2], e[3]); wk.x = cvt_pk_bf16(kt[0], kt[1]); wk.y = cvt_pk_bf16(kt[2], kt[3]); \
            *(pg8::u32x2*)(eqp + (size_t)(M) * 16 * 128) = we; *(pg8::u32x2*)(ukp + (size_t)(M) * 16 * 128) = wk; }
        HF_ST(b0, k0, 0) __builtin_amdgcn_sched_barrier(0); HF_ST(b1, k1, 1) __builtin_amdgcn_sched_barrier(0); HF_ST(b2, k2, 2) __builtin_amdgcn_sched_barrier(0); HF_ST(b3, k3, 3) __builtin_amdgcn_sched_barrier(0);
#undef HF_ST
        if (fr == 0) { f32x4 er, el;
#pragma unroll
            for (int j = 0; j < 4; ++j) { er[j] = __expf(r[j]); el[j] = __expf(bl[j] - r[j]); }
            *(f32x4*)(ER + (size_t)cidx * 512 + c) = er; *(f32x4*)(EL + (size_t)cidx * 512 + c) = el; }
    }
};
struct EpiOutProj {
    static constexpr bool PERM = true;
    const bf16* X; bf16* YB; float* ST;
    __device__ __forceinline__ void operator()(const f32x4 (&acc)[2][2][4][2], const Unit& u, int wr, int wc, int fr, int fq) const {
        const int row0 = u.pm * BM + wr * 64 + fr, col0 = u.pn * BM + wc * 32 + 8 * fq;
#pragma unroll
        for (int ai = 0; ai < 2; ++ai) {
            pg8::u32x4 xw[4][2];
#pragma unroll
            for (int m = 0; m < 4; ++m)
#pragma unroll
                for (int bj = 0; bj < 2; ++bj) xw[m][bj] = *(const pg8::u32x4*)(X + (size_t)(row0 + ai * HALF + m * 16) * D + col0 + bj * HALF);
#pragma unroll
            for (int m = 0; m < 4; ++m) { const size_t row = (size_t)(row0 + ai * HALF + m * 16); const size_t off = row * D + col0; float s = 0.f, q = 0.f;
#pragma unroll
                for (int bj = 0; bj < 2; ++bj) { const pg8::u32x4 x = xw[m][bj];
                    const f32x4 x0 = {bflo(x.x), bfhi(x.x), bflo(x.y), bfhi(x.y)}, x1 = {bflo(x.z), bfhi(x.z), bflo(x.w), bfhi(x.w)};
                    const f32x4 v0 = x0 * ALPHA + acc[ai][bj][m][0], v1 = x1 * ALPHA + acc[ai][bj][m][1];
                    pg8::u32x4 w; w.x = cvt_pk_bf16(v0[0], v0[1]); w.y = cvt_pk_bf16(v0[2], v0[3]); w.z = cvt_pk_bf16(v1[0], v1[1]); w.w = cvt_pk_bf16(v1[2], v1[3]);
                    *(pg8::u32x4*)(YB + off + bj * HALF) = w;
                    s += (v0[0] + v0[1]) + (v0[2] + v0[3]) + (v1[0] + v1[1]) + (v1[2] + v1[3]);
                    q += (v0[0] * v0[0] + v0[1] * v0[1]) + (v0[2] * v0[2] + v0[3] * v0[3]) + (v1[0] * v1[0] + v1[1] * v1[1]) + (v1[2] * v1[2] + v1[3] * v1[3]); }
                s += __shfl_xor(s, 16); s += __shfl_xor(s, 32); q += __shfl_xor(q, 16); q += __shfl_xor(q, 32);
                if (fq == 0) { atomicAdd(ST + 2 * row, s); atomicAdd(ST + 2 * row + 1, q); } }
            asm volatile("" ::: "memory"); }
    }
};
struct EpiGateUp {
    static constexpr bool PERM = true;
    bf16* H; const float* ST; const float* cs; const float* bw;
    __device__ __forceinline__ void operator()(const f32x4 (&acc)[2][2][4][2], const Unit& u, int wr, int wc, int fr, int fq) const {
        const int row0 = u.pm * BM + wr * 64 + fr, cw = wc * 32 + 8 * fq;
        const int bcol = u.pn * BM + cw;
        f32x4 cg[2], cu[2], bg[2], bu[2];
#pragma unroll
        for (int n = 0; n < 2; ++n) { cg[n] = *(const f32x4*)(cs + bcol + 4 * n); cu[n] = *(const f32x4*)(cs + bcol + HALF + 4 * n); bg[n] = *(const f32x4*)(bw + bcol + 4 * n); bu[n] = *(const f32x4*)(bw + bcol + HALF + 4 * n); }
#pragma unroll
        for (int ai = 0; ai < 2; ++ai)
#pragma unroll
            for (int m = 0; m < 4; ++m) { const size_t row = (size_t)(row0 + ai * HALF + m * 16);
                const f32x2 st = *(const f32x2*)(ST + 2 * row); const float mu = st.x * (1.0f / D), var = st.y * (1.0f / D) - mu * mu, r = rsqrtf(fmaxf(var, 0.f) + LN_EPS);
                f32x4 hv[2];
#pragma unroll
                for (int n = 0; n < 2; ++n) {
#pragma unroll
                    for (int j = 0; j < 4; ++j) { const float g = r * (acc[ai][0][m][n][j] - mu * cg[n][j]) + bg[n][j]; const float up = r * (acc[ai][1][m][n][j] - mu * cu[n][j]) + bu[n][j]; hv[n][j] = fsilu(g) * up; } }
                pg8::u32x4 w; w.x = cvt_pk_bf16(hv[0][0], hv[0][1]); w.y = cvt_pk_bf16(hv[0][2], hv[0][3]); w.z = cvt_pk_bf16(hv[1][0], hv[1][1]); w.w = cvt_pk_bf16(hv[1][2], hv[1][3]);
                *(pg8::u32x4*)(H + row * FF + u.pn * HALF + cw) = w; }
    }
};
struct EpiDown {
    static constexpr bool PERM = true;
    bf16* YB; const float* ST1; float* ST2; const float* g1; const float* b1;
    __device__ __forceinline__ void operator()(const f32x4 (&acc)[2][2][4][2], const Unit& u, int wr, int wc, int fr, int fq) const {
        const int row0 = u.pm * BM + wr * 64 + fr, col0 = u.pn * BM + wc * 32 + 8 * fq;
        f32x4 gv[2][2], bv[2][2];
#pragma unroll
        for (int bj = 0; bj < 2; ++bj)
#pragma unroll
            for (int n = 0; n < 2; ++n) { gv[bj][n] = *(const f32x4*)(g1 + col0 + bj * HALF + 4 * n); bv[bj][n] = *(const f32x4*)(b1 + col0 + bj * HALF + 4 * n); }
#pragma unroll
        for (int ai = 0; ai < 2; ++ai) {
            pg8::u32x4 yw[4][2]; f32x2 st[4];
#pragma unroll
            for (int m = 0; m < 4; ++m) { const size_t row = (size_t)(row0 + ai * HALF + m * 16); st[m] = *(const f32x2*)(ST1 + 2 * row);
#pragma unroll
                for (int bj = 0; bj < 2; ++bj) yw[m][bj] = *(const pg8::u32x4*)(YB + row * D + col0 + bj * HALF); }
#pragma unroll
            for (int m = 0; m < 4; ++m) { const size_t row = (size_t)(row0 + ai * HALF + m * 16); const size_t off = row * D + col0; float s = 0.f, q = 0.f;
                const float mu = st[m].x * (1.0f / D), var = st[m].y * (1.0f / D) - mu * mu, r = rsqrtf(fmaxf(var, 0.f) + LN_EPS);
#pragma unroll
                for (int bj = 0; bj < 2; ++bj) { const pg8::u32x4 y = yw[m][bj];
                    const f32x4 y0 = {bflo(y.x), bfhi(y.x), bflo(y.y), bfhi(y.y)}, y1 = {bflo(y.z), bfhi(y.z), bflo(y.w), bfhi(y.w)};
                    const f32x4 x0 = (y0 - mu) * r * gv[bj][0] + bv[bj][0], x1 = (y1 - mu) * r * gv[bj][1] + bv[bj][1];
                    const f32x4 v0 = x0 * ALPHA + acc[ai][bj][m][0], v1 = x1 * ALPHA + acc[ai][bj][m][1];
                    pg8::u32x4 w; w.x = cvt_pk_bf16(v0[0], v0[1]); w.y = cvt_pk_bf16(v0[2], v0[3]); w.z = cvt_pk_bf16(v1[0], v1[1]); w.w = cvt_pk_bf16(v1[2], v1[3]);
                    *(pg8::u32x4*)(YB + off + bj * HALF) = w;
                    s += (v0[0] + v0[1]) + (v0[2] + v0[3]) + (v1[0] + v1[1]) + (v1[2] + v1[3]);
                    q += (v0[0] * v0[0] + v0[1] * v0[1]) + (v0[2] * v0[2] + v0[3] * v0[3]) + (v1[0] * v1[0] + v1[1] * v1[1]) + (v1[2] * v1[2] + v1[3] * v1[3]); }
                s += __shfl_xor(s, 16); s += __shfl_xor(s, 32); q += __shfl_xor(q, 16); q += __shfl_xor(q, 32);
                if (fq == 0) { atomicAdd(ST2 + 2 * row, s); atomicAdd(ST2 + 2 * row + 1, q); } }
            asm volatile("" ::: "memory"); }
    }
};
struct EpiPleP {
    static constexpr bool PERM = true;
    pg8::u32x4* SCR;
    __device__ __forceinline__ void operator()(const f32x4 (&acc)[2][2][4][2], const Unit& u, int wr, int wc, int fr, int fq) const {
        pg8::u32x4* slab = SCR + (size_t)(u.pm * 4 + u.pn) * 8192 + threadIdx.x;
#pragma unroll
        for (int ai = 0; ai < 2; ++ai)
#pragma unroll
            for (int m = 0; m < 4; ++m)
#pragma unroll
                for (int bj = 0; bj < 2; ++bj) { const f32x4 v0 = acc[ai][bj][m][0], v1 = acc[ai][bj][m][1];
                    pg8::u32x4 w; w.x = cvt_pk_bf16(v0[0], v0[1]); w.y = cvt_pk_bf16(v0[2], v0[3]); w.z = cvt_pk_bf16(v1[0], v1[1]); w.w = cvt_pk_bf16(v1[2], v1[3]);
                    slab[((ai * 4 + m) * 2 + bj) * 512] = w; }
    }
};
struct EpiFinal {
    static constexpr bool PERM = true;
    float* OUT; const bf16* YB; const pg8::u32x4* SCR; const float* ST2; const float* g2; const float* b2; const float* cs; const float* bw; const float* bgate;
    __device__ __forceinline__ void operator()(const f32x4 (&acc)[2][2][4][2], const Unit& u, int wr, int wc, int fr, int fq) const {
        const int row0 = u.pm * BM + wr * 64 + fr, col0 = u.pn * BM + wc * 32 + 8 * fq;
        const pg8::u32x4* slab = SCR + (size_t)(u.pm * 4 + u.pn) * 8192 + threadIdx.x;
        float mu[2][4], rr[2][4];
#pragma unroll
        for (int ai = 0; ai < 2; ++ai)
#pragma unroll
            for (int m = 0; m < 4; ++m) { const size_t row = (size_t)(row0 + ai * HALF + m * 16);
                const f32x2 st = *(const f32x2*)(ST2 + 2 * row); const float mean = st.x * (1.0f / D), var = st.y * (1.0f / D) - mean * mean; mu[ai][m] = mean; rr[ai][m] = rsqrtf(fmaxf(var, 0.f) + LN_EPS); }
#pragma unroll
        for (int bj = 0; bj < 2; ++bj) { const int c = col0 + bj * HALF;
            f32x4 gv[2], bv[2], cv[2], wv[2];
#pragma unroll
            for (int n = 0; n < 2; ++n) { gv[n] = *(const f32x4*)(g2 + c + 4 * n); bv[n] = *(const f32x4*)(b2 + c + 4 * n); cv[n] = *(const f32x4*)(cs + c + 4 * n); wv[n] = *(const f32x4*)(bw + c + 4 * n) + *(const f32x4*)(bgate + c + 4 * n); }
#pragma unroll
            for (int ai = 0; ai < 2; ++ai) {
#pragma unroll
                for (int m = 0; m < 4; ++m) { const size_t off = (size_t)(row0 + ai * HALF + m * 16) * D + c;
                    const pg8::u32x4 yw = *(const pg8::u32x4*)(YB + off), pw = slab[((ai * 4 + m) * 2 + bj) * 512];
                    const f32x4 y[2] = {{bflo(yw.x), bfhi(yw.x), bflo(yw.y), bfhi(yw.y)}, {bflo(yw.z), bfhi(yw.z), bflo(yw.w), bfhi(yw.w)}};
                    const f32x4 pp[2] = {{bflo(pw.x), bfhi(pw.x), bflo(pw.y), bfhi(pw.y)}, {bflo(pw.z), bfhi(pw.z), bflo(pw.w), bfhi(pw.w)}};
                    const float mean = mu[ai][m], r = rr[ai][m];
#pragma unroll
                    for (int n = 0; n < 2; ++n) { const f32x4 x2 = (y[n] - mean) * r * gv[n] + bv[n]; f32x4 o;
#pragma unroll
                        for (int j = 0; j < 4; ++j) { const float gp = r * (acc[ai][bj][m][n][j] - mean * cv[n][j]) + wv[n][j]; o[j] = x2[j] + fsigmoid(gp) * pp[n][j]; }
                        *(f32x4*)(OUT + off + 4 * n) = o; } }
                asm volatile("" ::: "memory"); } }
    }
};

struct Frame {
    LAS unsigned char* lds;
    int tid, lane, wave, vcu, G;
};

template <int MAP>
__device__ __forceinline__ void p0_transpose_item(const float* W, int K, int ldw, int nblk, bf16* WT, const float* gk, const float* bk, float* cs, float* bw, LAS float* scr, int item, int lane) {
    const int kb = item / nblk, nb = item % nblk, k0 = 64 * kb, n0 = 32 * nb;
#pragma unroll 8
    for (int i = 0; i < 32; ++i) { const int kk = 2 * i + (lane >> 5); scr[kk * 33 + (lane & 31)] = W[(size_t)(k0 + kk) * ldw + n0 + (lane & 31)]; }
    LDS_WAIT(); asm volatile("" ::: "memory");
    const int c = lane & 7;
    float gs[8], bs[8];
#pragma unroll
    for (int e = 0; e < 8; ++e) { gs[e] = gk ? gk[k0 + 8 * c + e] : 1.0f; bs[e] = bk ? bk[k0 + 8 * c + e] : 0.0f; }
#pragma unroll
    for (int j = 0; j < 4; ++j) { const int n = (lane >> 3) + 8 * j; const LAS float* s = scr + (8 * c) * 33 + n;
        float w[8]; float sb = 0.f;
#pragma unroll
        for (int e = 0; e < 8; ++e) { const float raw = s[e * 33]; sb += bs[e] * raw; w[e] = raw * gs[e]; }
        v4u o; o.x = pk2(w[0], w[1]); o.y = pk2(w[2], w[3]); o.z = pk2(w[4], w[5]); o.w = pk2(w[6], w[7]);
        const int ng = n0 + n;
        const int row = (MAP == 0) ? ng : ((ng >> 7) * 256 + (ng & 127) + (MAP == 2 ? 128 : 0));
        *(GAS v4u*)(WT + (size_t)row * K + k0 + 8 * c) = o;
        if (cs) {
            float sc = (bflo(o.x) + bfhi(o.x)) + (bflo(o.y) + bfhi(o.y)) + (bflo(o.z) + bfhi(o.z)) + (bflo(o.w) + bfhi(o.w));
            sc += __shfl_xor(sc, 1); sc += __shfl_xor(sc, 2); sc += __shfl_xor(sc, 4);
            sb += __shfl_xor(sb, 1); sb += __shfl_xor(sb, 2); sb += __shfl_xor(sb, 4);
            if (c == 0) { atomicAdd(cs + row, sc); atomicAdd(bw + row, sb); }
        } }
    LDS_WAIT(); asm volatile("" ::: "memory");
}

struct Args { const float* in[20]; float* out; unsigned char* ws; int ph_lo, ph_hi, flags, pad; };

__device__ __forceinline__ void p0_prologue(const Frame& F, const Args& a) {
    unsigned char* ws = a.ws;
    LAS float* scr = (LAS float*)(F.lds + RING_OFF + F.wave * 16384);
    const int gw = F.vcu * NWAVES + F.wave, NGW = F.G * NWAVES;
    const float* w_in = a.in[2]; const float* w_out = a.in[9]; const float* wg = a.in[12]; const float* wu = a.in[13]; const float* wd = a.in[14]; const float* wpp = a.in[17]; const float* wpg = a.in[18];
    const float* ln1_g = a.in[10]; const float* ln1_b = a.in[11]; const float* ln2_g = a.in[15]; const float* ln2_b = a.in[16];
    float* cs_gu = (float*)(ws + WS_CTL + CTL_CS_GU); float* bw_gu = (float*)(ws + WS_CTL + CTL_BW_GU); float* cs_pg = (float*)(ws + WS_CTL + CTL_CS_PG); float* bw_pg = (float*)(ws + WS_CTL + CTL_BW_PG);
    constexpr int I_IN = (D / 64) * (NIN / 32), I_OUT = (D / 64) * (D / 32), I_G = (D / 64) * (FF / 32), I_DN = (FF / 64) * (D / 32), I_PG = I_OUT, I_PP = (PLE / 64) * (D / 32);
    constexpr int NITEMS = I_IN + I_OUT + 2 * I_G + I_DN + I_PG + I_PP;
    for (int it = gw; it < NITEMS; it += NGW) {
        int r = it;
        if (r < I_IN) { p0_transpose_item<0>(w_in, D, PROJW, NIN / 32, (bf16*)(ws + WS_WIN), nullptr, nullptr, nullptr, nullptr, scr, r, F.lane); continue; } r -= I_IN;
        if (r < I_OUT) { p0_transpose_item<0>(w_out, D, D, D / 32, (bf16*)(ws + WS_WOUT), nullptr, nullptr, nullptr, nullptr, scr, r, F.lane); continue; } r -= I_OUT;
        if (r < I_G) { p0_transpose_item<1>(wg, D, FF, FF / 32, (bf16*)(ws + WS_WGU), ln1_g, ln1_b, cs_gu, bw_gu, scr, r, F.lane); continue; } r -= I_G;
        if (r < I_G) { p0_transpose_item<2>(wu, D, FF, FF / 32, (bf16*)(ws + WS_WGU), ln1_g, ln1_b, cs_gu, bw_gu, scr, r, F.lane); continue; } r -= I_G;
        if (r < I_DN) { p0_transpose_item<0>(wd, FF, D, D / 32, (bf16*)(ws + WS_WDN), nullptr, nullptr, nullptr, nullptr, scr, r, F.lane); continue; } r -= I_DN;
        if (r < I_PG) { p0_transpose_item<0>(wpg, D, D, D / 32, (bf16*)(ws + WS_WPG), ln2_g, ln2_b, cs_pg, bw_pg, scr, r, F.lane); continue; } r -= I_PG;
        p0_transpose_item<0>(wpp, PLE, D, D / 32, (bf16*)(ws + WS_WPP), nullptr, nullptr, nullptr, nullptr, scr, r, F.lane);
    }
    if (gw == 0) { const float* lg = a.in[4]; float* oml = (float*)(ws + WS_OML);
        for (int c = F.lane; c < 512; c += 64) { const float l0 = lg[c], l1 = lg[512 + c]; const float mx = fmaxf(l0, l1); const float e0 = __expf(l0 - mx), e1 = __expf(l1 - mx); oml[c] = e1 / (e0 + e1); } }
    {
        const float* x = a.in[0]; const float* p = a.in[1]; const float* b_in = a.in[3];
        bf16* XB = (bf16*)(ws + WS_XB); bf16* PB = (bf16*)(ws + WS_PB); float* GATES = (float*)(ws + WS_GATES);
        f32x4 wl[2][8][2];
#pragma unroll
        for (int j = 0; j < 2; ++j)
#pragma unroll
            for (int e = 0; e < 8; ++e) { const float* wp = w_in + (size_t)(8 * F.lane + 512 * j + e) * PROJW + NIN; wl[j][e][0] = *(const f32x4*)wp; wl[j][e][1] = *(const f32x4*)(wp + 4); }
        const float bsel = b_in[NIN + (F.lane >> 3)];
        f32x4 na[2][2], npv;
        { const int m0 = gw < M ? gw : 0; const float* xr = x + (size_t)m0 * D;
#pragma unroll
          for (int j = 0; j < 2; ++j) { na[j][0] = *(const f32x4*)(xr + 8 * F.lane + 512 * j); na[j][1] = *(const f32x4*)(xr + 8 * F.lane + 512 * j + 4); }
          npv = *(const f32x4*)(p + (size_t)m0 * PLE + 4 * F.lane); }
        for (int m = gw; m < M; m += NGW) {
            f32x4 ca[2][2]; const f32x4 pv = npv;
#pragma unroll
            for (int j = 0; j < 2; ++j) { ca[j][0] = na[j][0]; ca[j][1] = na[j][1]; }
            { const int mn = (m + NGW < M) ? (m + NGW) : m; const float* xr = x + (size_t)mn * D;
#pragma unroll
              for (int j = 0; j < 2; ++j) { na[j][0] = *(const f32x4*)(xr + 8 * F.lane + 512 * j); na[j][1] = *(const f32x4*)(xr + 8 * F.lane + 512 * j + 4); }
              npv = *(const f32x4*)(p + (size_t)mn * PLE + 4 * F.lane); }
            f32x4 g0 = {0.f, 0.f, 0.f, 0.f}, g1 = {0.f, 0.f, 0.f, 0.f};
#pragma unroll
            for (int j = 0; j < 2; ++j) { const f32x4 a0 = ca[j][0], a1 = ca[j][1];
                v4u o; o.x = pk2(a0[0], a0[1]); o.y = pk2(a0[2], a0[3]); o.z = pk2(a1[0], a1[1]); o.w = pk2(a1[2], a1[3]);
                *(GAS v4u*)(XB + (size_t)m * D + 8 * F.lane + 512 * j) = o;
#pragma unroll
                for (int e = 0; e < 4; ++e) { g0 += wl[j][e][0] * a0[e]; g1 += wl[j][e][1] * a0[e]; g0 += wl[j][4 + e][0] * a1[e]; g1 += wl[j][4 + e][1] * a1[e]; } }
            const bool b5 = (F.lane & 32) != 0, b4 = (F.lane & 16) != 0, b3 = (F.lane & 8) != 0;
            float k4[4];
#pragma unroll
            for (int e = 0; e < 4; ++e) { const float keep = b5 ? g1[e] : g0[e], send = b5 ? g0[e] : g1[e]; k4[e] = keep + __shfl_xor(send, 32); }
            float k2[2];
#pragma unroll
            for (int e = 0; e < 2; ++e) { const float keep = b4 ? k4[2 + e] : k4[e], send = b4 ? k4[e] : k4[2 + e]; k2[e] = keep + __shfl_xor(send, 16); }
            float k1; { const float keep = b3 ? k2[1] : k2[0], send = b3 ? k2[0] : k2[1]; k1 = keep + __shfl_xor(send, 8); }
            k1 += __shfl_xor(k1, 4); k1 += __shfl_xor(k1, 2); k1 += __shfl_xor(k1, 1);
            if ((F.lane & 7) == 0) GATES[(size_t)m * 8 + (F.lane >> 3)] = k1 + bsel;
            v2u po; po.x = pk2(pv[0], pv[1]); po.y = pk2(pv[2], pv[3]);
            *(GAS v2u*)(PB + (size_t)m * PLE + 4 * F.lane) = po;
        }
    }
}

namespace mx {
typedef short s16x4 __attribute__((ext_vector_type(4)));
typedef short bf16x8 __attribute__((ext_vector_type(8)));
typedef short v4i16_t __attribute__((ext_vector_type(4)));
constexpr int NCH = 8;
constexpr int NSC = SEQ / (64 * NCH);
constexpr int NUNIT = 16 * NSC;
constexpr int L_QT = 0, L_KT = 16384, L_V = 32768, L_G = 49152, L_IMG = 65536  , L_XT = 131072, L_PART = 140288  ;
constexpr int XT_STRIDE = 144;
__device__ __forceinline__ unsigned off_b(unsigned row, unsigned ch) { return 256u * row + 16u * (ch ^ (((row & 3) << 2) | ((row >> 2) & 3))); }
__device__ __forceinline__ unsigned row_addr16(unsigned lane, unsigned rb, unsigned s) { return off_b((lane & 15) + 16 * rb, 4 * s + (lane >> 4)); }
__device__ __forceinline__ unsigned tr_addr16(unsigned lane, unsigned c, unsigned ks, unsigned t) { const unsigned g = lane >> 4, q = (lane & 15) >> 2, p = lane & 3;
    return off_b(32 * ks + 8 * g + 4 * t + q, 2 * c + (p >> 1)) + 8 * (p & 1); }
__device__ __forceinline__ unsigned perm_addr16(unsigned lane, unsigned rb, unsigned ks, unsigned half) { const unsigned g = lane >> 4;
    return off_b((lane & 15) + 16 * rb, 4 * ks + 2 * half + (g >> 1)) + 8 * (g & 1); }
__device__ __forceinline__ bf16x8 ld128(LAS unsigned char* L, unsigned off) { return *(const LAS bf16x8*)(L + off); }
__device__ __forceinline__ s16x4 ld64(LAS unsigned char* L, unsigned off) { return *(const LAS s16x4*)(L + off); }
__device__ __forceinline__ s16x4 ldtr(LAS unsigned char* L, unsigned off) { return __builtin_bit_cast(s16x4, __builtin_amdgcn_ds_read_tr16_b64_v4i16((LAS v4i16_t*)(L + off))); }
using pg8::cvt_pk_bf16;
__device__ __forceinline__ bf16x8 cat(s16x4 lo, s16x4 hi) { return (bf16x8){lo[0], lo[1], lo[2], lo[3], hi[0], hi[1], hi[2], hi[3]}; }
__device__ __forceinline__ bf16x8 pack8(const f32x4& a, const f32x4& b) { v4u w; w.x = cvt_pk_bf16(a[0], a[1]); w.y = cvt_pk_bf16(a[2], a[3]); w.z = cvt_pk_bf16(b[0], b[1]); w.w = cvt_pk_bf16(b[2], b[3]); return __builtin_bit_cast(bf16x8, w); }
#define MX_MFMA(a, b, c) __builtin_amdgcn_mfma_f32_16x16x32_bf16((a), (b), (c), 0, 0, 0)

template <int NKS>
__device__ __forceinline__ void x_tile(LAS unsigned char* L, LAS unsigned char* I, int lane, int sb, int tb) {
    f32x4 x = {0.f, 0.f, 0.f, 0.f};
#pragma unroll
    for (int ks = 0; ks < NKS; ++ks) x = MX_MFMA(ld128(I + L_KT, row_addr16(lane, sb, ks)), ld128(I + L_QT, row_addr16(lane, tb, ks)), x);
    const int g = lane >> 4, l15 = lane & 15;
#ifdef DBG_T5
    x = (f32x4){1.f, 1.f, 1.f, 1.f};
#endif
    if (sb == tb) {
#pragma unroll
        for (int i = 0; i < 4; ++i) x[i] = (4 * g + i <= l15) ? x[i] : 0.f;
    }
    v2u w; w.x = cvt_pk_bf16(x[0], x[1]); w.y = cvt_pk_bf16(x[2], x[3]);
    *(LAS v2u*)(L + L_XT + (16 * tb + l15) * XT_STRIDE + (16 * sb + 4 * g) * 2) = w;
}
template <int NKS>
__device__ __forceinline__ void x_all(LAS unsigned char* L, LAS unsigned char* I, int lane, int w) {
    switch (w) {
        case 0: x_tile<NKS>(L, I, lane, 0, 0); x_tile<NKS>(L, I, lane, 2, 3); break;
        case 1: x_tile<NKS>(L, I, lane, 0, 1); x_tile<NKS>(L, I, lane, 3, 3); break;
        case 2: x_tile<NKS>(L, I, lane, 1, 1); break;
        case 3: x_tile<NKS>(L, I, lane, 0, 2); break;
        case 4: x_tile<NKS>(L, I, lane, 1, 2); break;
        case 5: x_tile<NKS>(L, I, lane, 2, 2); break;
        case 6: x_tile<NKS>(L, I, lane, 0, 3); break;
        default: x_tile<NKS>(L, I, lane, 1, 3); break;
    }
}
__device__ __forceinline__ void x_zero(LAS unsigned char* L, int tid) {
    if (tid < 128) { const int which = tid >> 6, e = tid & 63, t = (which ? 32 : 0) + (e >> 2), s = (which ? 48 : 16) + 4 * (e & 3);
        v2u z; z.x = 0u; z.y = 0u; *(LAS v2u*)(L + L_XT + t * XT_STRIDE + s * 2) = z; }
}
__device__ __forceinline__ void out_pack(v2u (&ow)[4], const f32x4 (&O)[4], const float (&scale)[4], const f32x4& gn, const v2u (&gw)[4]) {
#pragma unroll
    for (int tb = 0; tb < 4; ++tb) { const float r = scale[tb];
        ow[tb].x = cvt_pk_bf16(O[tb][0] * r * gn[0] * bflo(gw[tb].x), O[tb][1] * r * gn[1] * bfhi(gw[tb].x)); ow[tb].y = cvt_pk_bf16(O[tb][2] * r * gn[2] * bflo(gw[tb].y), O[tb][3] * r * gn[3] * bfhi(gw[tb].y)); }
}
__device__ __forceinline__ void out_flush(bf16* orow, const v2u (&ow)[4]) {
#pragma unroll
    for (int tb = 0; tb < 4; ++tb) *(GAS v2u*)(orow + (size_t)(16 * tb) * D) = ow[tb];
}
#define MX_BAR() do { asm volatile("s_waitcnt lgkmcnt(0)" ::: "memory"); __builtin_amdgcn_s_barrier(); asm volatile("" ::: "memory"); } while (0)
constexpr int L_ERL = 144384;
constexpr int L_CW = 146432;
constexpr int L_GT = 148992;
constexpr int L_DEN = 153344;
constexpr int L_NST = 153856;

template <bool FULL>
__device__ __forceinline__ void hg_unit(const Frame& F, const Args& a, int uid) {
    unsigned char* ws = a.ws; LAS unsigned char* L = F.lds;
    const int tid = F.tid, w = F.wave;
    const int b = uid / (4 * NSC), h = (uid / NSC) & 3, sc = uid % NSC;
    const size_t row0 = (size_t)b * SEQ + (size_t)sc * (64 * NCH);
    const bf16* UQ = (const bf16*)(ws + WS_U + UO_Q) + (size_t)h * M * 128; const bf16* UK = (const bf16*)(ws + WS_U + UO_K) + (size_t)h * M * 128;
    const bf16* UV = (const bf16*)(ws + WS_U + UO_V) + (size_t)h * M * 128; const bf16* UG = (const bf16*)(ws + WS_U + UO_G) + (size_t)h * M * 128; const bf16* EQ = (const bf16*)(ws + WS_LOGF) + (size_t)h * M * 128;
    const float* ER = (const float*)(ws + WS_ER); const float* EL = (const float*)(ws + WS_EL);
    float* SST = (float*)(ws + (FULL ? WS_HGI : WS_HGS)) + (size_t)uid * 16384;
    bf16* OB = (bf16*)a.out;
    const int prow0 = tid >> 4, pch = tid & 15, prow1 = prow0 + 32;
    v4u rk[2], rv[2], rq[2], re[2], rg[2]; float rer = 0.f;
#define HG_LOAD(c) do { const size_t rowc_ = row0 + 64 * (c); \
        _Pragma("unroll") for (int i2 = 0; i2 < 2; ++i2) { const size_t eo = (rowc_ + (i2 ? prow1 : prow0)) * 128 + 8 * pch; \
            rk[i2] = *(const GAS v4u*)(UK + eo); rv[i2] = *(const GAS v4u*)(UV + eo); \
            if (FULL) { rq[i2] = *(const GAS v4u*)(UQ + eo); re[i2] = *(const GAS v4u*)(EQ + eo); rg[i2] = *(const GAS v4u*)(UG + eo); } } \
        if (tid < 256) rer = ((tid < 128) ? ER : EL)[(rowc_ >> 6) * 512 + h * 128 + (tid & 127)]; } while (0)
    HG_LOAD(0);
    f32x4 S[8];
    { const int lane = F.lane;
#pragma unroll
      for (int db = 0; db < 8; ++db) S[db] = FULL ? *(const f32x4*)(SST + ((w * 8 + db) * 64 + lane) * 4) : (f32x4){0.f, 0.f, 0.f, 0.f}; }
    f32x4 gn = {0.f, 0.f, 0.f, 0.f};
    if (FULL) { gn = *(const f32x4*)(a.in[7] + h * 128 + 16 * w + 4 * (F.lane >> 4)); x_zero(L, tid); }
    asm volatile("" : "+v"(gn));
#define HG_WRITE(P) do { LAS unsigned char* I_ = L + (P) * L_IMG; \
        _Pragma("unroll") for (int i2 = 0; i2 < 2; ++i2) { const unsigned o = off_b(i2 ? prow1 : prow0, pch); \
            *(LAS v4u*)(I_ + L_KT + o) = rk[i2]; *(LAS v4u*)(I_ + L_V + o) = rv[i2]; \
            if (FULL) { *(LAS v4u*)(I_ + L_G + o) = rg[i2]; const v4u q = rq[i2], e = re[i2]; \
                v4u qt; qt.x = cvt_pk_bf16(bflo(q.x) * bflo(e.x), bfhi(q.x) * bfhi(e.x)); qt.y = cvt_pk_bf16(bflo(q.y) * bflo(e.y), bfhi(q.y) * bfhi(e.y)); \
                qt.z = cvt_pk_bf16(bflo(q.z) * bflo(e.z), bfhi(q.z) * bfhi(e.z)); qt.w = cvt_pk_bf16(bflo(q.w) * bflo(e.w), bfhi(q.w) * bfhi(e.w)); \
                *(LAS v4u*)(I_ + L_QT + o) = qt; } } \
        if (tid < 256) *(LAS float*)(L + L_ERL + (P) * 1024 + tid * 4) = rer; } while (0)
    HG_WRITE(0); HG_LOAD(1);
    v2u ow[4] = {{0u, 0u}, {0u, 0u}, {0u, 0u}, {0u, 0u}};
    MX_BAR();
    for (int c = 0; c < NCH; ++c) {
        const size_t rowc = row0 + 64 * c; const int p = c & 1;
        int lane = F.lane; asm volatile("" : "+v"(lane));
        const int g = lane >> 4, l15 = lane & 15;
        LAS unsigned char* I = L + p * L_IMG; LAS unsigned char* E = L + L_ERL + p * 1024;
        __builtin_amdgcn_sched_barrier(0);
        if (c < NCH - 1) { HG_WRITE(p ^ 1); if (c < NCH - 2) HG_LOAD(c + 2); }
        if (FULL && c > 0) out_flush(OB + (rowc - 64 + l15) * D + h * 128 + 16 * w + 4 * g, ow);
        __builtin_amdgcn_sched_barrier(0);
        if (FULL) x_all<4>(L, I, lane, w);
#pragma unroll
        for (int db = 0; db < 8; ++db) S[db] *= *(const LAS f32x4*)(E + (16 * db + 4 * g) * 4);
        s16x4 vlo[2], vhi[2];
#pragma unroll
        for (int ks = 0; ks < 2; ++ks) { vlo[ks] = ldtr(I + L_V, tr_addr16(lane, w, ks, 0)); vhi[ks] = ldtr(I + L_V, tr_addr16(lane, w, ks, 1)); }
        f32x4 O[4];
        if (FULL) {
#pragma unroll
            for (int tb = 0; tb < 4; ++tb) O[tb] = (f32x4){0.f, 0.f, 0.f, 0.f};
#pragma unroll
            for (int ks = 0; ks < 4; ++ks) { const bf16x8 sa = pack8(S[2 * ks], S[2 * ks + 1]);
#pragma unroll
                for (int tb = 0; tb < 4; ++tb) O[tb] = MX_MFMA(sa, cat(ld64(I + L_QT, perm_addr16(lane, tb, ks, 0)), ld64(I + L_QT, perm_addr16(lane, tb, ks, 1))), O[tb]); }
        }
#pragma unroll
        for (int db = 0; db < 8; ++db) {
#pragma unroll
            for (int ks = 0; ks < 2; ++ks) S[db] = MX_MFMA(cat(ldtr(I + L_KT, tr_addr16(lane, db, ks, 0)), ldtr(I + L_KT, tr_addr16(lane, db, ks, 1))), cat(vlo[ks], vhi[ks]), S[db]);
            S[db] *= *(const LAS f32x4*)(E + (128 + 16 * db + 4 * g) * 4); }
        MX_BAR();
        if (FULL) {
            v2u gw[4];
#pragma unroll
            for (int tb = 0; tb < 4; ++tb) gw[tb] = *(const LAS v2u*)(I + L_G + off_b(16 * tb + l15, 2 * w + (g >> 1)) + 8 * (g & 1));
#pragma unroll
            for (int tb = 0; tb < 4; ++tb)
#pragma unroll
                for (int ks = 0; ks < 2; ++ks) if (ks <= (tb >> 1))
                    O[tb] = MX_MFMA(cat(vlo[ks], vhi[ks]), *(const LAS bf16x8*)(L + L_XT + (16 * tb + l15) * XT_STRIDE + (32 * ks + 8 * g) * 2), O[tb]);
#pragma unroll
            for (int tb = 0; tb < 4; ++tb) { float ss = (O[tb][0] * O[tb][0] + O[tb][1] * O[tb][1]) + (O[tb][2] * O[tb][2] + O[tb][3] * O[tb][3]);
                ss += __shfl_xor(ss, 16); ss += __shfl_xor(ss, 32);
                if (g == 0) *(LAS float*)(L + L_PART + (p * 512 + w * 64 + 16 * tb + l15) * 4) = ss; }
            MX_BAR();
            float scale[4];
#pragma unroll
            for (int tb = 0; tb < 4; ++tb) { float tot = 0.f;
#pragma unroll
                for (int ww = 0; ww < 8; ++ww) tot += *(const LAS float*)(L + L_PART + (p * 512 + ww * 64 + 16 * tb + l15) * 4);
                scale[tb] = rsqrtf(tot * (1.0f / 128.0f) + RMS_EPS); }
            out_pack(ow, O, scale, gn, gw);
        }
    }
#undef HG_WRITE
    if (FULL) out_flush(OB + (row0 + 64 * (NCH - 1) + (F.lane & 15)) * D + h * 128 + 16 * w + 4 * (F.lane >> 4), ow);
#undef HG_LOAD
    if (!FULL) {
        const int lane = F.lane;
#pragma unroll
        for (int db = 0; db < 8; ++db) *(f32x4*)(SST + ((w * 8 + db) * 64 + lane) * 4) = S[db];
        if (tid < 128) { float pr = 1.f;
            for (int c = 0; c < NCH; ++c) { const size_t cidx = (row0 >> 6) + c; pr *= ER[cidx * 512 + h * 128 + tid] * EL[cidx * 512 + h * 128 + tid]; }
            ((float*)(ws + WS_ASC))[(size_t)uid * 128 + tid] = pr; }
    }
    MX_BAR();
}

template <bool FULL>
__device__ __forceinline__ void ml_unit(const Frame& F, const Args& a, int uid) {
    unsigned char* ws = a.ws; LAS unsigned char* L = F.lds;
    const int tid = F.tid, w = F.wave;
    const int b = uid / (4 * NSC), h = (uid / NSC) & 3, sc = uid % NSC;
    const size_t row0 = (size_t)b * SEQ + (size_t)sc * (64 * NCH);
    const bf16* MQ = (const bf16*)(ws + WS_U + UO_MQ) + (size_t)h * M * 64; const bf16* MK = (const bf16*)(ws + WS_U + UO_MK) + (size_t)h * M * 64;
    const bf16* MV = (const bf16*)(ws + WS_U + UO_MV) + (size_t)h * M * 128; const bf16* MO = (const bf16*)(ws + WS_U + UO_MO) + (size_t)h * M * 128; const float* GATES = (const float*)(ws + WS_GATES);
    float* SST = (float*)(ws + (FULL ? WS_MLCI : WS_MLC)) + (size_t)uid * 8192;
    float* MLS = (float*)(ws + WS_MLS) + (size_t)uid * 4; float* MLN = (float*)(ws + (FULL ? WS_MLNI : WS_MLN)) + (size_t)uid * 64;
    bf16* OB = (bf16*)a.out;
    LAS float* GT = (LAS float*)(L + L_GT); LAS float* CW = (LAS float*)(L + L_CW); LAS float* DEN = (LAS float*)(L + L_DEN); LAS float* NST = (LAS float*)(L + L_NST);
    const int crow = tid >> 3, cch = tid & 7;
    const int prow0 = tid >> 4, pch = tid & 15, prow1 = prow0 + 32;
    v4u xk[4], xq[4], rv[2], rg[2];
#define ML_LOAD(c) do { const long tseq0_ = (long)sc * (64 * NCH) + 64 * (c) + crow - 3; \
        _Pragma("unroll") for (int k = 0; k < 4; ++k) { const long ts = tseq0_ + k; xk[k] = (v4u){0u, 0u, 0u, 0u}; xq[k] = (v4u){0u, 0u, 0u, 0u}; \
            if (ts >= 0) { const size_t eo = ((size_t)b * SEQ + ts) * 64 + 8 * cch; xk[k] = *(const GAS v4u*)(MK + eo); if (FULL) xq[k] = *(const GAS v4u*)(MQ + eo); } } \
        _Pragma("unroll") for (int i2 = 0; i2 < 2; ++i2) { const size_t eo = (row0 + 64 * (c) + (i2 ? prow1 : prow0)) * 128 + 8 * pch; rv[i2] = *(const GAS v4u*)(MV + eo); if (FULL) rg[i2] = *(const GAS v4u*)(MO + eo); } } while (0)
    ML_LOAD(0);
    f32x4 S[4];
    { const int lane = F.lane;
#pragma unroll
      for (int db = 0; db < 4; ++db) S[db] = FULL ? *(const f32x4*)(SST + ((w * 4 + db) * 64 + lane) * 4) : (f32x4){0.f, 0.f, 0.f, 0.f}; }
    if (tid < 64) NST[tid] = FULL ? MLN[tid] : 0.f;
    if (tid >= 64 && tid < 192) { const int cc = tid - 64; const float* cw = a.in[5]; const float* cb = a.in[6]; const int gc = (cc < 64) ? (h * 64 + cc) : (256 + h * 64 + cc - 64);
#pragma unroll
        for (int k = 0; k < 4; ++k) CW[k * 128 + cc] = cw[k * 512 + gc];
        CW[512 + cc] = cb[gc]; }
    f32x4 gn = {0.f, 0.f, 0.f, 0.f};
    if (FULL) { gn = *(const f32x4*)(a.in[8] + h * 128 + 16 * w + 4 * (F.lane >> 4)); x_zero(L, tid); }
    asm volatile("" : "+v"(gn));
    if (w == 7) { const int lane = F.lane;
        float m_run = FULL ? ((const float*)(ws + WS_MLI))[uid] : -1.0e30f, gsum = 0.f;
        float igv[NCH], fgv[NCH];
#pragma unroll
        for (int c = 0; c < NCH; ++c) { igv[c] = GATES[(row0 + 64 * c + lane) * 8 + h]; fgv[c] = GATES[(row0 + 64 * c + lane) * 8 + 4 + h]; }
#pragma unroll
        for (int c = 0; c < NCH; ++c) {
            const float ig = igv[c], fgp = fgv[c];
            float gc = fminf(fgp, 0.f) - __logf(1.0f + __expf(-fabsf(fgp)));
#define ML_DPPF(x, old, ctrl, rmask, bc) __builtin_bit_cast(float, __builtin_amdgcn_update_dpp(__builtin_bit_cast(int, (old)), __builtin_bit_cast(int, (x)), (ctrl), (rmask), 0xF, (bc)))
            gc += ML_DPPF(gc, 0.f, 0x111, 0xF, true); gc += ML_DPPF(gc, 0.f, 0x112, 0xF, true); gc += ML_DPPF(gc, 0.f, 0x114, 0xF, true); gc += ML_DPPF(gc, 0.f, 0x118, 0xF, true);
            gc += ML_DPPF(gc, 0.f, 0x142, 0xA, false); gc += ML_DPPF(gc, 0.f, 0x143, 0xC, false);
            const float av = ig - gc; float amax = av;
            amax = fmaxf(amax, ML_DPPF(amax, amax, 0x111, 0xF, false)); amax = fmaxf(amax, ML_DPPF(amax, amax, 0x112, 0xF, false)); amax = fmaxf(amax, ML_DPPF(amax, amax, 0x114, 0xF, false)); amax = fmaxf(amax, ML_DPPF(amax, amax, 0x118, 0xF, false));
            amax = fmaxf(amax, ML_DPPF(amax, amax, 0x142, 0xA, false)); amax = fmaxf(amax, ML_DPPF(amax, amax, 0x143, 0xC, false));
            amax = __builtin_bit_cast(float, __builtin_amdgcn_readlane(__builtin_bit_cast(int, amax), 63));
#undef ML_DPPF
            const float mu = fmaxf(m_run, amax);
            GT[c * 128 + lane] = __expf(av - mu); GT[c * 128 + 64 + lane] = __expf(-(gc + mu));
            const float gl = __builtin_bit_cast(float, __builtin_amdgcn_readlane(__builtin_bit_cast(int, gc), 63));
            if (lane == 0) { GT[NCH * 128 + 4 * c] = __expf(m_run - mu); }
            m_run = gl + mu; gsum += gl; }
        if (lane == 0) { GT[NCH * 132] = m_run; GT[NCH * 132 + 1] = gsum; } }
    MX_BAR();
#define ML_WRITE(P, CC) do { LAS unsigned char* I_ = L + (P) * L_IMG; \
        const LAS float* cq = CW + 8 * cch; const LAS float* ck = CW + 64 + 8 * cch; \
        const unsigned o = off_b(crow, cch); \
        { f32x4 kacc0 = *(const LAS f32x4*)(ck + 512), kacc1 = *(const LAS f32x4*)(ck + 516); \
          _Pragma("unroll") for (int k = 0; k < 4; ++k) { const f32x4 wk0 = *(const LAS f32x4*)(ck + 128 * k), wk1 = *(const LAS f32x4*)(ck + 128 * k + 4); \
            kacc0[0] += wk0[0] * bflo(xk[k].x); kacc0[1] += wk0[1] * bfhi(xk[k].x); kacc0[2] += wk0[2] * bflo(xk[k].y); kacc0[3] += wk0[3] * bfhi(xk[k].y); \
            kacc1[0] += wk1[0] * bflo(xk[k].z); kacc1[1] += wk1[1] * bfhi(xk[k].z); kacc1[2] += wk1[2] * bflo(xk[k].w); kacc1[3] += wk1[3] * bfhi(xk[k].w); } \
          const float scl = GT[(CC) * 128 + crow]; \
          _Pragma("unroll") for (int e = 0; e < 4; ++e) { kacc0[e] = fsilu(kacc0[e]) * scl; kacc1[e] = fsilu(kacc1[e]) * scl; } \
          *(LAS bf16x8*)(I_ + L_KT + o) = pack8(kacc0, kacc1); } \
        __builtin_amdgcn_sched_barrier(0); \
        if (FULL) { f32x4 qacc0 = *(const LAS f32x4*)(cq + 512), qacc1 = *(const LAS f32x4*)(cq + 516); \
          _Pragma("unroll") for (int k = 0; k < 4; ++k) { const f32x4 wq0 = *(const LAS f32x4*)(cq + 128 * k), wq1 = *(const LAS f32x4*)(cq + 128 * k + 4); \
            qacc0[0] += wq0[0] * bflo(xq[k].x); qacc0[1] += wq0[1] * bfhi(xq[k].x); qacc0[2] += wq0[2] * bflo(xq[k].y); qacc0[3] += wq0[3] * bfhi(xq[k].y); \
            qacc1[0] += wq1[0] * bflo(xq[k].z); qacc1[1] += wq1[1] * bfhi(xq[k].z); qacc1[2] += wq1[2] * bflo(xq[k].w); qacc1[3] += wq1[3] * bfhi(xq[k].w); } \
          _Pragma("unroll") for (int e = 0; e < 4; ++e) { qacc0[e] = fsilu(qacc0[e]) * 0.125f; qacc1[e] = fsilu(qacc1[e]) * 0.125f; } \
          *(LAS bf16x8*)(I_ + L_QT + o) = pack8(qacc0, qacc1); } \
        __builtin_amdgcn_sched_barrier(0); \
        _Pragma("unroll") for (int i2 = 0; i2 < 2; ++i2) { const unsigned o2 = off_b(i2 ? prow1 : prow0, pch); *(LAS v4u*)(I_ + L_V + o2) = rv[i2]; if (FULL) *(LAS v4u*)(I_ + L_G + o2) = rg[i2]; } } while (0)
    ML_WRITE(0, 0); ML_LOAD(1);
    v2u ow[4] = {{0u, 0u}, {0u, 0u}, {0u, 0u}, {0u, 0u}};
    MX_BAR();
    for (int c = 0; c < NCH; ++c) {
        const size_t rowc = row0 + 64 * c; const int p = c & 1;
        int lane = F.lane; asm volatile("" : "+v"(lane));
        const int g = lane >> 4, l15 = lane & 15;
        LAS unsigned char* I = L + p * L_IMG;
        const float wv = GT[NCH * 128 + 4 * c];
        __builtin_amdgcn_sched_barrier(0);
        if (c < NCH - 1) { ML_WRITE(p ^ 1, c + 1); if (c < NCH - 2) ML_LOAD(c + 2); }
        if (FULL && c > 0) out_flush(OB + (rowc - 64 + l15) * D + 512 + h * 128 + 16 * w + 4 * g, ow);
        __builtin_amdgcn_sched_barrier(0);
        if (FULL) x_all<2>(L, I, lane, w);
#pragma unroll
        for (int db = 0; db < 4; ++db) S[db] *= wv;
        s16x4 vlo[2], vhi[2];
#pragma unroll
        for (int ks = 0; ks < 2; ++ks) { vlo[ks] = ldtr(I + L_V, tr_addr16(lane, w, ks, 0)); vhi[ks] = ldtr(I + L_V, tr_addr16(lane, w, ks, 1)); }
        __builtin_amdgcn_sched_barrier(0);
        f32x4 O[4];
        if (FULL) {
#pragma unroll
            for (int tb = 0; tb < 4; ++tb) O[tb] = (f32x4){0.f, 0.f, 0.f, 0.f};
#pragma unroll
            for (int ks = 0; ks < 2; ++ks) { const bf16x8 sa = pack8(S[2 * ks], S[2 * ks + 1]);
#pragma unroll
                for (int tb = 0; tb < 4; ++tb) O[tb] = MX_MFMA(sa, cat(ld64(I + L_QT, perm_addr16(lane, tb, ks, 0)), ld64(I + L_QT, perm_addr16(lane, tb, ks, 1))), O[tb]); }
        }
        __builtin_amdgcn_sched_barrier(0);
#pragma unroll
        for (int db = 0; db < 4; ++db)
#pragma unroll
            for (int ks = 0; ks < 2; ++ks) S[db] = MX_MFMA(cat(ldtr(I + L_KT, tr_addr16(lane, db, ks, 0)), ldtr(I + L_KT, tr_addr16(lane, db, ks, 1))), cat(vlo[ks], vhi[ks]), S[db]);
        __builtin_amdgcn_sched_barrier(0);
        if (w == 1) { const int rg = lane >> 3, ch = lane & 7; float cs[8] = {0.f, 0.f, 0.f, 0.f, 0.f, 0.f, 0.f, 0.f};
#pragma unroll
            for (int r8 = 0; r8 < 8; ++r8) { const v4u kv = *(const LAS v4u*)(I + L_KT + off_b(8 * rg + r8, ch));
                cs[0] += bflo(kv.x); cs[1] += bfhi(kv.x); cs[2] += bflo(kv.y); cs[3] += bfhi(kv.y); cs[4] += bflo(kv.z); cs[5] += bfhi(kv.z); cs[6] += bflo(kv.w); cs[7] += bfhi(kv.w); }
#pragma unroll
            for (int e = 0; e < 8; ++e) { cs[e] += __shfl_xor(cs[e], 8); cs[e] += __shfl_xor(cs[e], 16); cs[e] += __shfl_xor(cs[e], 32); }
            if (lane < 8) {
#pragma unroll
                for (int e = 0; e < 8; ++e) NST[(p ^ 1) * 64 + 8 * lane + e] = wv * NST[p * 64 + 8 * lane + e] + cs[e]; } }
        MX_BAR();
        if (FULL) {
            v2u gw[4];
#pragma unroll
            for (int tb = 0; tb < 4; ++tb) gw[tb] = *(const LAS v2u*)(I + L_G + off_b(16 * tb + l15, 2 * w + (g >> 1)) + 8 * (g & 1));
#pragma unroll
            for (int tb = 0; tb < 4; ++tb)
#pragma unroll
                for (int ks = 0; ks < 2; ++ks) if (ks <= (tb >> 1))
                    O[tb] = MX_MFMA(cat(vlo[ks], vhi[ks]), *(const LAS bf16x8*)(L + L_XT + (16 * tb + l15) * XT_STRIDE + (32 * ks + 8 * g) * 2), O[tb]);
            if (w == 1) { float sx = 0.f, qn = 0.f;
#pragma unroll
                for (int ch = 0; ch < 8; ++ch) { const v4u xv = *(const LAS v4u*)(L + L_XT + lane * XT_STRIDE + 16 * ch);
                    if (ch < 2 * ((lane >> 4) + 1)) sx += (bflo(xv.x) + bfhi(xv.x)) + (bflo(xv.y) + bfhi(xv.y)) + (bflo(xv.z) + bfhi(xv.z)) + (bflo(xv.w) + bfhi(xv.w));
                    const v4u qv = *(const LAS v4u*)(I + L_QT + off_b(lane, ch)); const LAS float* nn = NST + p * 64 + 8 * ch;
                    qn += bflo(qv.x) * nn[0] + bfhi(qv.x) * nn[1] + bflo(qv.y) * nn[2] + bfhi(qv.y) * nn[3] + bflo(qv.z) * nn[4] + bfhi(qv.z) * nn[5] + bflo(qv.w) * nn[6] + bfhi(qv.w) * nn[7]; }
                DEN[p * 64 + lane] = sx + wv * qn; }
#pragma unroll
            for (int tb = 0; tb < 4; ++tb) { float ss = (O[tb][0] * O[tb][0] + O[tb][1] * O[tb][1]) + (O[tb][2] * O[tb][2] + O[tb][3] * O[tb][3]);
                ss += __shfl_xor(ss, 16); ss += __shfl_xor(ss, 32);
                if (g == 0) *(LAS float*)(L + L_PART + (p * 512 + w * 64 + 16 * tb + l15) * 4) = ss; }
            MX_BAR();
            float scale[4];
#pragma unroll
            for (int tb = 0; tb < 4; ++tb) { const int t = 16 * tb + l15; float tot = 0.f;
#pragma unroll
                for (int ww = 0; ww < 8; ++ww) tot += *(const LAS float*)(L + L_PART + (p * 512 + ww * 64 + t) * 4);
                const float dd = fmaxf(fabsf(DEN[p * 64 + t]), GT[c * 128 + 64 + t]);
                scale[tb] = rsqrtf(tot * (1.0f / 128.0f) + RMS_EPS * dd * dd); }
            out_pack(ow, O, scale, gn, gw);
        }
    }
#undef ML_WRITE
    if (FULL) out_flush(OB + (row0 + 64 * (NCH - 1) + (F.lane & 15)) * D + 512 + h * 128 + 16 * w + 4 * (F.lane >> 4), ow);
#undef ML_LOAD
    if (!FULL) {
        const int lane = F.lane;
#pragma unroll
        for (int db = 0; db < 4; ++db) *(f32x4*)(SST + ((w * 4 + db) * 64 + lane) * 4) = S[db];
        if (tid < 64) MLN[tid] = NST[tid];
        if (tid == 0) { MLS[0] = GT[NCH * 132 + 1]; MLS[1] = GT[NCH * 132]; }
    }
    MX_BAR();
}

template <bool FULL>
__device__ __forceinline__ void mixer_pass(const Frame& F, const Args& a) {
    if (F.vcu & 1) {
        for (int u = F.vcu; u < NUNIT; u += F.G) ml_unit<FULL>(F, a, u);
        for (int u = F.vcu; u < NUNIT; u += F.G) hg_unit<FULL>(F, a, u);
    } else {
        for (int u = F.vcu; u < NUNIT; u += F.G) hg_unit<FULL>(F, a, u);
        for (int u = F.vcu; u < NUNIT; u += F.G) ml_unit<FULL>(F, a, u);
    }
}
__device__ __forceinline__ void scan_pass(const Frame& F, const Args& a) {
    unsigned char* ws = a.ws;
    const size_t gt = (size_t)F.vcu * (NWAVES * 64) + F.tid, GT = (size_t)F.G * (NWAVES * 64);
    const float* HGS = (const float*)(ws + WS_HGS); const float* MLSt = (const float*)(ws + WS_MLC);
    float* HGI = (float*)(ws + WS_HGI); float* MLCI = (float*)(ws + WS_MLCI); float* MLNI = (float*)(ws + WS_MLNI); float* MLI = (float*)(ws + WS_MLI);
    const float* ASC = (const float*)(ws + WS_ASC); const float* MLS = (const float*)(ws + WS_MLS); const float* MLN = (const float*)(ws + WS_MLN);
    constexpr size_t N_HG = 16 * 4096, N_MLC = 16 * 2048, N_MLN = 16 * 16;
    for (size_t e0 = gt; e0 < N_HG + N_MLC + N_MLN; e0 += GT) {
        if (e0 < N_HG) { const int bh = (int)(e0 >> 12), e4 = (int)(e0 & 4095); const int d = 16 * ((e4 >> 6) & 7) + 4 * ((e4 & 63) >> 4);
            f32x4 run = {0.f, 0.f, 0.f, 0.f};
            for (int s0 = 0; s0 < NSC; s0 += 16) { f32x4 loc[16], av[16];
#pragma unroll
                for (int k = 0; k < 16; ++k) { const size_t uid = (size_t)bh * NSC + s0 + k; loc[k] = *(const f32x4*)(HGS + uid * 16384 + 4 * e4); av[k] = *(const f32x4*)(ASC + uid * 128 + d); }
#pragma unroll
                for (int k = 0; k < 16; ++k) { const size_t uid = (size_t)bh * NSC + s0 + k; *(f32x4*)(HGI + uid * 16384 + 4 * e4) = run; run = av[k] * run + loc[k]; } }
        } else { const size_t e1 = e0 - N_HG; const bool isn = e1 >= N_MLC; const int bh = isn ? (int)((e1 - N_MLC) >> 4) : (int)(e1 >> 11), e4 = isn ? (int)((e1 - N_MLC) & 15) : (int)(e1 & 2047);
            f32x4 run = {0.f, 0.f, 0.f, 0.f}; float m = 0.f;
            for (int s0 = 0; s0 < NSC; s0 += 16) { f32x4 loc[16]; float Gv[16], mlv[16];
#pragma unroll
                for (int k = 0; k < 16; ++k) { const size_t uid = (size_t)bh * NSC + s0 + k; Gv[k] = MLS[uid * 4]; mlv[k] = MLS[uid * 4 + 1];
                    loc[k] = isn ? *(const f32x4*)(MLN + uid * 64 + 4 * e4) : *(const f32x4*)(MLSt + uid * 8192 + 4 * e4); }
#pragma unroll
                for (int k = 0; k < 16; ++k) { const size_t uid = (size_t)bh * NSC + s0 + k;
                    if (isn) *(f32x4*)(MLNI + uid * 64 + 4 * e4) = run; else *(f32x4*)(MLCI + uid * 8192 + 4 * e4) = run;
                    if (!isn && e4 == 0) MLI[uid] = m;
                    const float mn = fmaxf(m + Gv[k], mlv[k]); run = run * __expf(m + Gv[k] - mn) + loc[k] * __expf(mlv[k] - mn); m = mn; } }
        }
    }
}
}

__global__ void __launch_bounds__(NWAVES * 64, 2) hymba_fwd(Args args) {
    extern __shared__ __attribute__((aligned(16))) unsigned char lds[];
    Frame F;
    F.lds = (LAS unsigned char*)lds;
    F.tid = threadIdx.x; F.lane = F.tid & 63; F.wave = __builtin_amdgcn_readfirstlane(F.tid >> 6);
    F.G = gridDim.x; { const int bx = blockIdx.x; F.vcu = (F.G % 8 == 0) ? (bx % 8) * (F.G / 8) + bx / 8 : bx; }
    unsigned char* ws = args.ws;
    volatile LAS unsigned* MISC = (volatile LAS unsigned*)(F.lds + MISC_OFF);
    for (int u = F.tid; u < (LDS_BYTES - LDSCTL_OFF) / 4; u += NWAVES * 64) ((LAS unsigned*)(F.lds + LDSCTL_OFF))[u] = 0u;
    __syncthreads();
    XcdBarrier bar; bar.bar = (unsigned*)(ws + WS_CTL) + CW_BAR; bar.x = 0; bar.st = nullptr;
    if (N_LAUNCHES == 1) bar = xcd_barrier_post((unsigned*)(ws + WS_CTL) + CW_BAR, MISC + 8);
    const int lo = args.ph_lo, hi = args.ph_hi;
#ifndef PH_MASK
#define PH_MASK 0x1ff
#endif
#define IN(k) (((PH_MASK >> (k)) & 1) && lo <= (k) && (k) < hi)
#define BOTH(k) (IN(k) && IN((k) + 1))
#define GRID_BAR() do { if (N_LAUNCHES == 1) xcd_barrier(bar); } while (0)

    if (IN(0)) { p0_prologue(F, args); if (BOTH(0)) GRID_BAR(); }
    if (IN(1)) {
        pg8::Gemm g{(const bf16*)(ws + WS_XB), (const bf16*)(ws + WS_WIN), M, NIN, D}; pg8::StaticOrder S; S.init(M, NIN, F.G, (int)blockIdx.x);
        EpiInProj E{(bf16*)(ws + WS_U), (bf16*)(ws + WS_LOGF), (float*)(ws + WS_ER), (float*)(ws + WS_EL), args.in[3], (const float*)(ws + WS_OML)};
        pg8::gemm_phase<EpiInProj, pg8::StaticOrder, PG8_ALIGN, PG8_SP2>(F.lds + RING_OFF, g, S, E);
        if (BOTH(1)) GRID_BAR();
    }
    if (IN(2)) { mx::mixer_pass<false>(F, args); if (BOTH(2)) GRID_BAR(); }
    if (IN(3)) { mx::scan_pass(F, args);
        if (BOTH(3)) GRID_BAR(); }
    if (IN(4)) { mx::mixer_pass<true>(F, args);
        if (BOTH(4)) GRID_BAR(); }
    if (IN(5)) {
        pg8::Gemm g{(const bf16*)args.out, (const bf16*)(ws + WS_WOUT), M, D, D}; pg8::StaticOrder S; S.init(M, D, F.G, (int)blockIdx.x);
        EpiOutProj E{(const bf16*)(ws + WS_XB), (bf16*)(ws + WS_LOGF), (float*)(ws + WS_CTL + ((args.flags & 1) ? 768 * 1024 : CTL_ST1))};
        pg8::gemm_phase<EpiOutProj, pg8::StaticOrder, PG8_ALIGN, PG8_SP2>(F.lds + RING_OFF, g, S, E);
        if (BOTH(5)) GRID_BAR();
    }
    if (IN(6)) {
        pg8::Gemm g{(const bf16*)(ws + WS_LOGF), (const bf16*)(ws + WS_WGU), M, NGU, D}; pg8::StaticOrder S; S.init(M, NGU, F.G, (int)blockIdx.x);
        EpiGateUp E{(bf16*)(ws + WS_U), (const float*)(ws + WS_CTL + CTL_ST1), (const float*)(ws + WS_CTL + CTL_CS_GU), (const float*)(ws + WS_CTL + CTL_BW_GU)};
        pg8::gemm_phase<EpiGateUp, pg8::StaticOrder, PG8_ALIGN, PG8_SP2>(F.lds + RING_OFF, g, S, E);
        if (BOTH(6)) GRID_BAR();
    }
    if (IN(7)) {
        pg8::Gemm g{(const bf16*)(ws + WS_U), (const bf16*)(ws + WS_WDN), M, D, FF}; pg8::StaticOrder S; S.init(M, D, F.G, (int)blockIdx.x);
        EpiDown E{(bf16*)(ws + WS_LOGF), (const float*)(ws + WS_CTL + CTL_ST1), (float*)(ws + WS_CTL + CTL_ST2), args.in[10], args.in[11]};
        pg8::gemm_phase<EpiDown, pg8::StaticOrder, PG8_ALIGN, PG8_SP2>(F.lds + RING_OFF, g, S, E);
    }
    if (IN(8)) {
#ifndef NO_PGEMM
        {   int kp = PLE; asm volatile("" : "+s"(kp));
            pg8::Gemm g{(const bf16*)(ws + WS_PB), (const bf16*)(ws + WS_WPP), M, D, kp}; pg8::StaticOrder S; S.init(M, D, F.G, (int)blockIdx.x);
            EpiPleP E{(pg8::u32x4*)(ws + WS_XB)};
            pg8::gemm_phase<EpiPleP, pg8::StaticOrder, PG8_ALIGN, PG8_SP2>(F.lds + RING_OFF, g, S, E); }
#endif
        VM_WAIT(); __syncthreads();
        if (BOTH(7)) GRID_BAR();
#ifndef NO_FGEMM
        {   pg8::Gemm g{(const bf16*)(ws + WS_LOGF), (const bf16*)(ws + WS_WPG), M, D, D}; pg8::StaticOrder S; S.init(M, D, F.G, (int)blockIdx.x);
            EpiFinal E{args.out, (const bf16*)(ws + WS_LOGF), (const pg8::u32x4*)(ws + WS_XB), (const float*)(ws + WS_CTL + CTL_ST2), args.in[15], args.in[16], (const float*)(ws + WS_CTL + CTL_CS_PG), (const float*)(ws + WS_CTL + CTL_BW_PG), args.in[19]};
            pg8::gemm_phase<EpiFinal, pg8::StaticOrder, PG8_ALIGN, PG8_SP2>(F.lds + RING_OFF, g, S, E); }
#endif
    }
#undef IN
#undef BOTH
#undef GRID_BAR
}

extern "C" void kernel_launch(void* const* d_in, const int* in_sizes, int n_in, void* d_out, int out_size, void* d_ws, size_t ws_size, hipStream_t stream) {
    static int grid = 0;
    if (grid == 0) {
        if (n_in != 20 || in_sizes[0] != M * D || out_size != M * D || ws_size < WS_END) { fprintf(stderr, "kernel_launch: unexpected shapes: n_in %d in0 %d out %d ws %zu (need %zu)\n", n_in, n_in > 0 ? in_sizes[0] : -1, out_size, ws_size, (size_t)WS_END); grid = -1; return; }
        int dev = 0, cus = 0, per_cu = 0;
        if (hipGetDevice(&dev) != hipSuccess || hipDeviceGetAttribute(&cus, hipDeviceAttributeMultiprocessorCount, dev) != hipSuccess) { grid = -1; return; }
        if (hipFuncSetAttribute((const void*)hymba_fwd, hipFuncAttributeMaxDynamicSharedMemorySize, LDS_BYTES) != hipSuccess) { fprintf(stderr, "kernel_launch: hipFuncSetAttribute failed\n"); grid = -1; return; }
        if (hipOccupancyMaxActiveBlocksPerMultiprocessor(&per_cu, (const void*)hymba_fwd, NWAVES * 64, LDS_BYTES) != hipSuccess || per_cu < 1)
            fprintf(stderr, "kernel_launch: note: occupancy query reports %d workgroups per CU\n", per_cu);
        (void)hipGetLastError();
        grid = cus;
    }
    if (grid < 0) return;
    if (hipMemsetAsync((char*)d_ws + WS_CTL, 0, CTL_ZERO_BYTES, stream) != hipSuccess) { fprintf(stderr, "kernel_launch: memset failed\n"); return; }
    Args a{};
    for (int i = 0; i < 20; ++i) a.in[i] = (const float*)d_in[i];
    a.out = (float*)d_out; a.ws = (unsigned char*)d_ws;
    if (N_LAUNCHES == 1) { a.ph_lo = 0; a.ph_hi = NPHASE; hipLaunchKernelGGL(hymba_fwd, dim3(grid), dim3(NWAVES * 64), LDS_BYTES, stream, a); }
    else for (int li = 0; li < NPHASE; ++li) { a.ph_lo = li; a.ph_hi = li + 1;
#ifdef PROBE_PHASE
        if (li == PROBE_PHASE) { a.flags = 1; hipLaunchKernelGGL(hymba_fwd, dim3(grid), dim3(NWAVES * 64), LDS_BYTES, stream, a); a.flags = 0; }
#endif
        hipLaunchKernelGGL(hymba_fwd, dim3(grid), dim3(NWAVES * 64), LDS_BYTES, stream, a); }
}
```

```cpp
#include <hip/hip_runtime.h>
#include <cstdio>
#include <cstdint>


#ifndef MK_N_LAUNCHES
#define MK_N_LAUNCHES 1
#endif

namespace pg8 {
#define PG8_LAS __attribute__((address_space(3)))
typedef unsigned short bf16_t;
typedef short bf16x8 __attribute__((ext_vector_type(8)));
typedef float f32x4 __attribute__((ext_vector_type(4)));
typedef float f32x2 __attribute__((ext_vector_type(2)));
typedef unsigned u32x4 __attribute__((ext_vector_type(4)));
typedef unsigned u32x2 __attribute__((ext_vector_type(2)));
constexpr int BM = 256, BK = 64, HALF = 128, HTB = HALF * BK * 2, STAGE_BYTES = 8 * HTB, NXCD = 8, WGM = 8;

__host__ __device__ __forceinline__ int lds_byte(int r, int c) { const int st = (r >> 4) * 2 + (c >> 5), rr = r & 15, cc = c & 31, ob = rr * 64 + cc * 2; return st * 1024 + (ob ^ (((ob >> 9) & 1) << 5)); }
__host__ __device__ __forceinline__ void stage_rc(int b, int& R, int& C) { const int st = b / 1024, sb = b % 1024, swz = sb ^ (((sb >> 9) & 1) << 5); R = (st >> 1) * 16 + swz / 64; C = (st & 1) * 32 + (swz % 64) / 2; }
__host__ __device__ __forceinline__ int perm32(int rho) { const int n = rho >> 4, i = rho & 15; return 8 * (i >> 2) + 4 * n + (i & 3); }

struct Unit { int pm, pn; };
struct Gemm { const bf16_t* A; const bf16_t* Bt; int M, N, K; };

struct StaticOrder {
    int nM, nN, nwg, G, c;
    __host__ __device__ void init(int M, int N, int G_, int c_) { nM = M / BM; nN = N / BM; nwg = nM * nN; G = G_; c = c_; }
    __host__ __device__ bool next(int i, Unit& u) const {
        const long L = (long)i * G + c; if (L >= nwg) return false;
        int wgid = (int)L; { const int q = nwg / NXCD, r = nwg % NXCD, xcd = wgid % NXCD, off = wgid / NXCD; wgid = (xcd < r ? xcd * (q + 1) : r * (q + 1) + (xcd - r) * q) + off; }
        const int nig = WGM * nN, gid = wgid / nig, fm = gid * WGM, gsz = (nM - fm) < WGM ? (nM - fm) : WGM;
        u.pm = fm + ((wgid % nig) % gsz); u.pn = (wgid % nig) / gsz; return true;
    }
    __device__ __forceinline__ void a_ready(const Unit&) const {}
    __device__ __forceinline__ void done(const Unit&) const {}
};

typedef __bf16 bf16v2_t __attribute__((ext_vector_type(2)));
__device__ __forceinline__ unsigned cvt_pk_bf16(float lo, float hi) { const f32x2 v = {lo, hi}; return __builtin_bit_cast(unsigned, __builtin_convertvector(v, bf16v2_t)); }

template <class Epi, class Sched, bool ALIGN_EPI = false, bool SP2 = false>
__device__ __forceinline__ void gemm_phase(PG8_LAS unsigned char* lds, const Gemm g, const Sched& S, const Epi& E) {
    const int tid = threadIdx.x, wid = __builtin_amdgcn_readfirstlane(tid >> 6), lane = tid & 63, wr = wid >> 2, wc = wid & 3, fr = lane & 15, fq = lane >> 4;
    const int K = g.K, nt = K / BK;
    unsigned voffA[2], voffB[2];
#pragma unroll
    for (int i = 0; i < 2; ++i) { int R, C; stage_rc(tid * 16 + i * 8192, R, C); const int Rb = Epi::PERM ? ((R & ~31) + perm32(R & 31)) : R;
        voffA[i] = (unsigned)(R * K + C) * 2u; voffB[i] = (unsigned)(Rb * K + C) * 2u; }
    const size_t kstep = (size_t)(BK * 2);
    const size_t hstep = (size_t)HALF * K * 2;
    const size_t tstep = 2 * hstep;
    const unsigned ldsw = (unsigned)wid * 1024u;
    const int aoff = lds_byte(wr * 64 + fr, fq * 8), boff = lds_byte(wc * 32 + fr, fq * 8);
#define PG8_SA(b, h) (((b) * 2 + (h)) * HTB)
#define PG8_SB(b, h) ((4 + (b) * 2 + (h)) * HTB)
#define PG8_STAGE(bufoff, gbase, voff) do { _Pragma("unroll") for (int _i = 0; _i < 2; ++_i) \
        __builtin_amdgcn_global_load_lds((const unsigned*)((const char*)(gbase) + (voff)[_i]), (PG8_LAS unsigned*)(lds + (bufoff) + ldsw + _i * 8192), 16, 0, 0); } while (0)
#define PG8_LDA(dst, b, h) do { _Pragma("unroll") for (int m = 0; m < 4; ++m) _Pragma("unroll") for (int k = 0; k < 2; ++k) dst[m][k] = *(const PG8_LAS bf16x8*)(lds + PG8_SA(b, h) + aoff + m * 2048 + k * 1024); } while (0)
#define PG8_LDB(dst, b, h) do { _Pragma("unroll") for (int n = 0; n < 2; ++n) _Pragma("unroll") for (int k = 0; k < 2; ++k) dst[n][k] = *(const PG8_LAS bf16x8*)(lds + PG8_SB(b, h) + boff + n * 2048 + k * 1024); } while (0)
#define PG8_MMA(ai, bj, At, Bt) do { __builtin_amdgcn_s_setprio(1); _Pragma("unroll") for (int m = 0; m < 4; ++m) _Pragma("unroll") for (int n = 0; n < 2; ++n) _Pragma("unroll") for (int k = 0; k < 2; ++k) \
        acc[ai][bj][m][n] = __builtin_amdgcn_mfma_f32_16x16x32_bf16(Bt[n][k], At[m][k], acc[ai][bj][m][n], 0, 0, 0); __builtin_amdgcn_s_setprio(0); } while (0)
#define PG8_WAIT_V(n) asm volatile("s_waitcnt vmcnt(" #n ")" ::: "memory")
#define PG8_WAIT_L(n) asm volatile("s_waitcnt lgkmcnt(" #n ")" ::: "memory")
#define PG8_BAR __builtin_amdgcn_s_barrier()
#define PG8_SCHED __builtin_amdgcn_sched_barrier(0)
    Unit cur, nxt; int ui = 0;
    if (!S.next(0, cur)) return;
    f32x4 acc[2][2][4][2];
#pragma unroll
    for (int a = 0; a < 2; ++a)
#pragma unroll
        for (int b = 0; b < 2; ++b)
#pragma unroll
            for (int m = 0; m < 4; ++m)
#pragma unroll
                for (int n = 0; n < 2; ++n) acc[a][b][m][n] = (f32x4){0.f, 0.f, 0.f, 0.f};
    bf16x8 At[4][2], B0[2][2], B1[2][2];
    const char* cA = (const char*)g.A + (size_t)cur.pm * tstep; const char* cB = (const char*)g.Bt + (size_t)cur.pn * tstep;
    S.a_ready(cur);
    if constexpr (SP2) {
        PG8_STAGE(PG8_SB(0, 0), cB, voffB); PG8_STAGE(PG8_SB(0, 1), cB + hstep, voffB); PG8_STAGE(PG8_SA(0, 0), cA, voffA); PG8_STAGE(PG8_SA(0, 1), cA + hstep, voffA);
        if (wr == 1) PG8_BAR;
        PG8_WAIT_V(2); PG8_BAR;
        PG8_STAGE(PG8_SB(1, 0), cB + kstep, voffB); PG8_STAGE(PG8_SA(1, 0), cA + kstep, voffA); PG8_STAGE(PG8_SB(1, 1), cB + hstep + kstep, voffB);
        PG8_WAIT_V(6); PG8_BAR;
    } else {
        PG8_STAGE(PG8_SB(0, 0), cB, voffB); PG8_STAGE(PG8_SA(0, 0), cA, voffA); PG8_STAGE(PG8_SB(0, 1), cB + hstep, voffB); PG8_STAGE(PG8_SA(0, 1), cA + hstep, voffA);
        if (wr == 1) PG8_BAR;
        PG8_WAIT_V(4); PG8_BAR;
        PG8_STAGE(PG8_SB(1, 0), cB + kstep, voffB); PG8_STAGE(PG8_SA(1, 0), cA + kstep, voffA); PG8_STAGE(PG8_SB(1, 1), cB + hstep + kstep, voffB);
        PG8_WAIT_V(6); PG8_BAR;
    }
    for (;;) {
        const bool has_next = S.next(ui + 1, nxt);
        const char* nA = has_next ? (const char*)g.A + (size_t)nxt.pm * tstep : cA; const char* nB = has_next ? (const char*)g.Bt + (size_t)nxt.pn * tstep : cB;
        for (int t = 0; t < nt; t += 2) {
            const bool last = (t == nt - 2);
            const char* a1 = cA + (size_t)(t + 1) * kstep;
            const char* a2 = last ? nA : cA + (size_t)(t + 2) * kstep; const char* b2 = last ? nB : cB + (size_t)(t + 2) * kstep;
            const char* a3 = a2 + kstep; const char* b3 = b2 + kstep;
            if (last && has_next) S.a_ready(nxt);
            if constexpr (SP2) {
            PG8_LDB(B0, 0, 0); PG8_LDB(B1, 0, 1); PG8_SCHED; PG8_LDA(At, 0, 0); PG8_STAGE(PG8_SA(1, 1), a1 + hstep, voffA);
            PG8_WAIT_V(8); PG8_WAIT_L(0); PG8_BAR; PG8_MMA(0, 0, At, B0); PG8_MMA(0, 1, At, B1); PG8_BAR; PG8_SCHED;
            PG8_LDA(At, 0, 1); PG8_STAGE(PG8_SB(0, 0), b2, voffB); PG8_STAGE(PG8_SB(0, 1), b2 + hstep, voffB); PG8_STAGE(PG8_SA(0, 0), a2, voffA);
            PG8_WAIT_V(8); PG8_WAIT_L(0); PG8_BAR; PG8_MMA(1, 0, At, B0); PG8_MMA(1, 1, At, B1); PG8_BAR; PG8_SCHED;
            PG8_LDB(B0, 1, 0); PG8_LDB(B1, 1, 1); PG8_SCHED; PG8_LDA(At, 1, 0); PG8_STAGE(PG8_SA(0, 1), a2 + hstep, voffA);
            PG8_WAIT_V(8); PG8_WAIT_L(0); PG8_BAR; PG8_MMA(0, 0, At, B0); PG8_MMA(0, 1, At, B1); PG8_BAR; PG8_SCHED;
            PG8_LDA(At, 1, 1); PG8_STAGE(PG8_SB(1, 0), b3, voffB); PG8_STAGE(PG8_SB(1, 1), b3 + hstep, voffB); PG8_STAGE(PG8_SA(1, 0), a3, voffA);
            PG8_WAIT_V(8); PG8_WAIT_L(0); PG8_BAR; PG8_MMA(1, 0, At, B0); PG8_MMA(1, 1, At, B1); PG8_BAR; PG8_SCHED;
            } else {
            PG8_LDB(B0, 0, 0); PG8_SCHED; PG8_LDA(At, 0, 0); PG8_STAGE(PG8_SA(1, 1), a1 + hstep, voffA);
            PG8_WAIT_L(8); PG8_BAR; PG8_WAIT_L(0); PG8_MMA(0, 0, At, B0); PG8_BAR; PG8_SCHED;
            PG8_LDB(B1, 0, 1); PG8_STAGE(PG8_SB(0, 0), b2, voffB);
            PG8_BAR; PG8_WAIT_L(0); PG8_MMA(0, 1, At, B1); PG8_BAR;
            PG8_LDA(At, 0, 1); PG8_STAGE(PG8_SA(0, 0), a2, voffA);
            PG8_BAR; PG8_WAIT_L(0); PG8_MMA(1, 0, At, B0); PG8_BAR; PG8_SCHED;
            PG8_STAGE(PG8_SB(0, 1), b2 + hstep, voffB);
            PG8_WAIT_V(6); PG8_BAR; PG8_MMA(1, 1, At, B1); PG8_BAR;
            PG8_LDB(B0, 1, 0); PG8_SCHED; PG8_LDA(At, 1, 0); PG8_STAGE(PG8_SA(0, 1), a2 + hstep, voffA);
            PG8_WAIT_L(8); PG8_BAR; PG8_WAIT_L(0); PG8_MMA(0, 0, At, B0); PG8_BAR; PG8_SCHED;
            PG8_LDB(B1, 1, 1); PG8_STAGE(PG8_SB(1, 0), b3, voffB);
            PG8_BAR; PG8_WAIT_L(0); PG8_MMA(0, 1, At, B1); PG8_BAR;
            PG8_LDA(At, 1, 1); PG8_STAGE(PG8_SA(1, 0), a3, voffA);
            PG8_BAR; PG8_WAIT_L(0); PG8_MMA(1, 0, At, B0); PG8_BAR; PG8_SCHED;
            PG8_STAGE(PG8_SB(1, 1), b3 + hstep, voffB);
            PG8_WAIT_V(6); PG8_BAR; PG8_MMA(1, 1, At, B1); PG8_BAR;
            }
        }
        if constexpr (ALIGN_EPI) { if (wr == 0) PG8_BAR; }
        E(acc, cur, wr, wc, fr, fq); S.done(cur);
        if (!has_next) break;
#pragma unroll
        for (int a = 0; a < 2; ++a)
#pragma unroll
            for (int b = 0; b < 2; ++b)
#pragma unroll
                for (int m = 0; m < 4; ++m)
#pragma unroll
                    for (int n = 0; n < 2; ++n) acc[a][b][m][n] = (f32x4){0.f, 0.f, 0.f, 0.f};
        cur = nxt; cA = nA; cB = nB; ++ui;
        if constexpr (ALIGN_EPI) { if (wr == 1) PG8_BAR; }
    }
    PG8_WAIT_V(0);
    if constexpr (!ALIGN_EPI) { if (wr == 0) PG8_BAR; }
    PG8_BAR;
#undef PG8_SA
#undef PG8_SB
#undef PG8_STAGE
#undef PG8_LDA
#undef PG8_LDB
#undef PG8_MMA
#undef PG8_WAIT_V
#undef PG8_WAIT_L
#undef PG8_BAR
#undef PG8_SCHED
}
}

#ifndef PG8_SP2
#define PG8_SP2 true
#endif
#ifndef PG8_ALIGN
#define PG8_ALIGN true
#endif

constexpr int NWAVES = 8;
constexpr int NPHASE = 9;
constexpr int N_LAUNCHES = MK_N_LAUNCHES;
constexpr int BATCH = 4, SEQ = 8192, D = 1024, M = BATCH * SEQ, PLE = 256, FF = 2816;
constexpr int PROJW = 3592, NIN = 3584;
constexpr int NGU = 2 * FF;
constexpr size_t MiB0 = 1u << 20;
constexpr float ALPHA = 1.189207115002721f;
constexpr float LN_EPS = 1e-5f, RMS_EPS = 1e-6f;
constexpr size_t UO_Q = 0, UO_K = 32 * MiB0, UO_V = 64 * MiB0, UO_G = 96 * MiB0, UO_MQ = 128 * MiB0, UO_MK = 144 * MiB0, UO_MV = 160 * MiB0, UO_MO = 192 * MiB0;
constexpr int C_HQ = 0, C_HF = 512, C_HV = 1024, C_HG = 1536, C_MQ = 2048, C_MK = 2304, C_MV = 2560, C_MO = 3072;

constexpr size_t MiB = 1u << 20;
constexpr size_t WS_CTL = 0, CTL_ZERO_BYTES = 1 * MiB;
constexpr int CW_BAR = 4096;
constexpr size_t CTL_CS_GU = 64 * 1024, CTL_BW_GU = CTL_CS_GU + NGU * 4, CTL_CS_PG = CTL_BW_GU + NGU * 4, CTL_BW_PG = CTL_CS_PG + D * 4;
static_assert(CTL_BW_PG + D * 4 <= 128 * 1024, "ctl vectors");
constexpr size_t CTL_ST1 = 256 * 1024, CTL_ST2 = 512 * 1024;
static_assert(CTL_ST2 + (size_t)M * 8 <= CTL_ZERO_BYTES, "ctl stats");
constexpr size_t WS_OML = 1 * MiB;
constexpr size_t WS_WIN = 2 * MiB;
constexpr size_t WS_WOUT = 9 * MiB;
constexpr size_t WS_WGU = 11 * MiB;
constexpr size_t WS_WDN = 22 * MiB;
constexpr size_t WS_WPG = 28 * MiB;
constexpr size_t WS_WPP = 30 * MiB;
constexpr size_t WS_GATES = 31 * MiB;
constexpr size_t WS_XB = 32 * MiB;
constexpr size_t WS_PB = 96 * MiB;
constexpr size_t WS_U = 112 * MiB;
constexpr size_t WS_LOGF = 336 * MiB;
constexpr size_t WS_ER = 400 * MiB;
constexpr size_t WS_EL = 401 * MiB;
constexpr size_t WS_ASC = 402 * MiB;
constexpr size_t WS_MLS = 403 * MiB;
constexpr size_t WS_MLN = 404 * MiB;
constexpr size_t WS_HGS = 408 * MiB;
constexpr size_t WS_MLC = 440 * MiB;
constexpr size_t WS_HGI = 456 * MiB;
constexpr size_t WS_MLCI = 488 * MiB;
constexpr size_t WS_MLNI = 504 * MiB;
constexpr size_t WS_MLI = 505 * MiB;
constexpr size_t WS_END = 506 * MiB;

constexpr int RING_OFF = 0, RING_BYTES = 131072;
constexpr int LDS_BYTES = 163840;
constexpr int LDSCTL_OFF = LDS_BYTES - 1024, MISC_OFF = LDSCTL_OFF + 320;

#define GAS __attribute__((address_space(1)))
#define LAS __attribute__((address_space(3)))
typedef unsigned short bf16;
typedef unsigned v4u __attribute__((ext_vector_type(4)));
typedef unsigned v2u __attribute__((ext_vector_type(2)));
typedef float f32x4 __attribute__((ext_vector_type(4)));
typedef float f32x2 __attribute__((ext_vector_type(2)));
typedef GAS unsigned gu32;
#define RLX_AGENT __ATOMIC_RELAXED, __HIP_MEMORY_SCOPE_AGENT
#define LDS_WAIT() asm volatile("s_waitcnt lgkmcnt(0)" ::: "memory")
#define VM_WAIT() asm volatile("s_waitcnt vmcnt(0)" ::: "memory")
__device__ __forceinline__ unsigned f2bf(float f) { unsigned u = __builtin_bit_cast(unsigned, f); return (u + 0x7fffu + ((u >> 16) & 1u)) >> 16; }
__device__ __forceinline__ unsigned pk2(float lo, float hi) { return f2bf(lo) | (f2bf(hi) << 16); }
__device__ __forceinline__ float bf2f(unsigned short b) { return __builtin_bit_cast(float, (unsigned)b << 16); }
__device__ __forceinline__ float bflo(unsigned w) { return __builtin_bit_cast(float, w << 16); }
__device__ __forceinline__ float bfhi(unsigned w) { return __builtin_bit_cast(float, w & 0xffff0000u); }
__device__ __forceinline__ float fsigmoid(float x) { return __builtin_amdgcn_rcpf(1.0f + __expf(-x)); }
__device__ __forceinline__ float fsilu(float x) { return x * fsigmoid(x); }
__device__ __forceinline__ float wave_sum(float v) {
#pragma unroll
    for (int o = 1; o < 64; o <<= 1) v += __shfl_xor(v, o);
    return v;
}

#define XB_TMO      128
#define XB_XCNT(j)  (256  + 64 * (j))
#define XB_XSUB(j)  (1280 + 64 * (j))
#define XB_XGEN(j)  (2304 + 64 * (j))
#define XB_TOP      3328
#define XB_TOPGEN   3392
#define XCD_BAR_WORDS 3456
#define XB_SPIN_CAP (1u << 22)
__device__ __forceinline__ unsigned xb_ld(unsigned* p)              { return __hip_atomic_load(p, __ATOMIC_RELAXED, __HIP_MEMORY_SCOPE_AGENT); }
__device__ __forceinline__ unsigned xb_add(unsigned* p, unsigned v) { return __hip_atomic_fetch_add(p, v, __ATOMIC_RELAXED, __HIP_MEMORY_SCOPE_AGENT); }
__device__ __forceinline__ unsigned xb_xcc_id() { return (unsigned)__builtin_amdgcn_s_getreg((3 << 11) | 20) & 0xFu; }
#define XB_SPIN(cond, bar) do { unsigned _sp = 0; while (cond) { __builtin_amdgcn_s_sleep(1); \
    if ((++_sp & 255u) == 0u) { if (xb_ld(&(bar)[XB_TMO])) break; if (_sp > XB_SPIN_CAP) { atomicAdd(&(bar)[XB_TMO], 1u); break; } } } } while (0)
struct XcdBarrier { unsigned* bar; unsigned x; volatile LAS unsigned* st; };
__device__ __forceinline__ XcdBarrier xcd_barrier_post(unsigned* bar, volatile LAS unsigned* st) {
    XcdBarrier b; b.bar = bar; b.x = xb_xcc_id(); b.st = st;
    if (threadIdx.x == 0) (void)xb_add(&bar[XB_XCNT(b.x)], 1u);
    return b;
}
__device__ __forceinline__ void xcd_barrier_complete(unsigned* bar, unsigned x, unsigned& nloc, unsigned& nx) {
    const unsigned G = gridDim.x * gridDim.y * gridDim.z;
    unsigned sum, cnt, mine, sp = 0u;
    for (;;) {
        sum = 0u; cnt = 0u; mine = 0u;
#pragma unroll
        for (unsigned j = 0; j < 16; ++j) { const unsigned c = xb_ld(&bar[XB_XCNT(j)]); sum += c; cnt += (c > 0u) ? 1u : 0u; mine = (j == x) ? c : mine; }
        if (sum == G) break;
        __builtin_amdgcn_s_sleep(1);
        if ((++sp & 255u) == 0u) { if (xb_ld(&bar[XB_TMO])) break; if (sp > XB_SPIN_CAP) { atomicAdd(&bar[XB_TMO], 1u); break; } }
    }
    nloc = mine > 0u ? mine : 1u; nx = cnt > 0u ? cnt : 1u;
}
__device__ __forceinline__ void xcd_barrier(const XcdBarrier& b) {
    asm volatile("s_waitcnt vmcnt(0)" ::: "memory");
    __syncthreads();
    if (threadIdx.x == 0) {
        unsigned* bar = b.bar;
        __builtin_amdgcn_s_waitcnt(0);
        unsigned nloc = b.st[0], nx = b.st[1];
        if (nloc == 0u) { xcd_barrier_complete(bar, b.x, nloc, nx); b.st[0] = nloc; b.st[1] = nx; }
        const unsigned old = xb_add(&bar[XB_XSUB(b.x)], 1u);
        const unsigned gen = old / nloc;
        if (old + 1u == (gen + 1u) * nloc) {
            __builtin_amdgcn_fence(__ATOMIC_RELEASE, "agent");
            asm volatile("s_waitcnt vmcnt(0)" ::: "memory");
            const unsigned og = xb_add(&bar[XB_TOP], 1u);
            const unsigned tg = og / nx;
            if (og + 1u == (tg + 1u) * nx) xb_add(&bar[XB_TOPGEN], 1u);
            else XB_SPIN(xb_ld(&bar[XB_TOPGEN]) == tg, bar);
            __builtin_amdgcn_fence(__ATOMIC_ACQUIRE, "agent");
            xb_add(&bar[XB_XGEN(b.x)], 1u);
            asm volatile("s_waitcnt vmcnt(0)" ::: "memory");
        } else {
            XB_SPIN(xb_ld(&bar[XB_XGEN(b.x)]) == gen, bar);
            __builtin_amdgcn_fence(__ATOMIC_ACQUIRE, "agent");
            asm volatile("s_waitcnt vmcnt(0)" ::: "memory");
        }
    }
    __syncthreads();
}

using pg8::Unit; using pg8::cvt_pk_bf16; using pg8::HALF; using pg8::BM;
#define HF_DPP(x, ctrl) __builtin_bit_cast(float, __builtin_amdgcn_update_dpp(0, __builtin_bit_cast(int, (x)), (ctrl), 0xF, 0xF, true))
struct EpiInProj {
    static constexpr bool PERM = true;
    bf16* U; bf16* EQ; float* ER; float* EL; const float* bias; const float* oml;
    __device__ __forceinline__ void operator()(const f32x4 (&acc)[2][2][4][2], const Unit& u, int wr, int wc, int fr, int fq) const {
        const int row0 = u.pm * BM + wr * 64 + fr, col0 = u.pn * BM + wc * 32 + 8 * fq;
        const int pn = u.pn;
        const int type = (pn < 4) ? 3 : (pn < 6) ? 0 : (pn < 8) ? 1 : (pn < 12) ? 0 : 2;
        if (type != 3) {
            f32x4 bv[2][2];
#pragma unroll
            for (int bj = 0; bj < 2; ++bj)
#pragma unroll
                for (int n = 0; n < 2; ++n) bv[bj][n] = *(const f32x4*)(bias + col0 + bj * HALF + 4 * n);
            const size_t tbase = (pn < 6) ? UO_V : (pn < 8) ? UO_G : (pn == 8) ? UO_MQ : (pn == 9) ? UO_MK : (pn < 12) ? UO_MV : UO_MO;
            const bool narrow = (pn == 8) || (pn == 9);
            const int hpair = narrow ? 0 : 2 * (pn & 1);
            bf16* dst[2];
#pragma unroll
            for (int bj = 0; bj < 2; ++bj) { const int head = narrow ? (2 * bj + (wc >> 1)) : (hpair + bj); const int colh = narrow ? ((wc & 1) * 32 + 8 * fq) : (wc * 32 + 8 * fq);
                dst[bj] = (bf16*)((char*)U + tbase) + (size_t)head * M * (narrow ? 64 : 128) + colh; }
            const int W = narrow ? 64 : 128;
#pragma unroll
            for (int ai = 0; ai < 2; ++ai)
#pragma unroll
                for (int m = 0; m < 4; ++m) { const size_t row = (size_t)(row0 + ai * HALF + m * 16);
#pragma unroll
                    for (int bj = 0; bj < 2; ++bj) { f32x4 v0 = acc[ai][bj][m][0] + bv[bj][0], v1 = acc[ai][bj][m][1] + bv[bj][1];
                        if (type == 1) {
#pragma unroll
                            for (int j = 0; j < 4; ++j) { v0[j] = fsilu(v0[j]); v1[j] = fsilu(v1[j]); }
                        } else if (type == 2) {
#pragma unroll
                            for (int j = 0; j < 4; ++j) { v0[j] = fsigmoid(v0[j]); v1[j] = fsigmoid(v1[j]); }
                        }
                        pg8::u32x4 w; w.x = cvt_pk_bf16(v0[0], v0[1]); w.y = cvt_pk_bf16(v0[2], v0[3]); w.z = cvt_pk_bf16(v1[0], v1[1]); w.w = cvt_pk_bf16(v1[2], v1[3]);
                        *(pg8::u32x4*)(dst[bj] + row * W) = w; } }
        } else {
            const int ch = wc * 32 + 8 * fq;
#pragma unroll
            for (int ai = 0; ai < 2; ++ai) { const int cidx = u.pm * 4 + ai * 2 + wr;
#pragma unroll
                for (int n = 0; n < 2; ++n) { const size_t hoff = ((size_t)pn * M + (size_t)(row0 + ai * HALF)) * 128 + ch + 4 * n;
                    hf_block(acc[ai][1][0][n], acc[ai][1][1][n], acc[ai][1][2][n], acc[ai][1][3][n], acc[ai][0][0][n], acc[ai][0][1][n], acc[ai][0][2][n], acc[ai][0][3][n],
                             pn * 128 + ch + 4 * n, (bf16*)((char*)U + UO_Q) + hoff, (bf16*)((char*)U + UO_K) + hoff, cidx, fr); } }
        }
    }
    static __device__ __forceinline__ float hf_total(float scanv) {
        float o = scanv - HF_DPP(scanv, 0x111);
        o += HF_DPP(o, 0x128); o += HF_DPP(o, 0x124); o += HF_DPP(o, 0x122); o += HF_DPP(o, 0x121); return o; }
    __device__ __forceinline__ void hf_block(const f32x4& a0, const f32x4& a1, const f32x4& a2, const f32x4& a3, const f32x4& q0, const f32x4& q1, const f32x4& q2, const f32x4& q3, int c, bf16* uqp, bf16* ukp, int cidx, int fr) const {
        const f32x4 bv = *(const f32x4*)(bias + C_HF + c), ov = *(const f32x4*)(oml + c), bq = *(const f32x4*)(bias + C_HQ + c);
        f32x4 k0, k1, k2, k3, l0, l1, l2, l3;
#define HF_SCAN { x += HF_DPP(x, 0x111); x += HF_DPP(x, 0x112); x += HF_DPP(x, 0x114); x += HF_DPP(x, 0x118); }
#define HF_BC(v) hf_total(v)
#define HF_ONE(A, KK, LL) _Pragma("unroll") for (int j = 0; j < 4; ++j) { const float k = ov[j] * fsigmoid(-(A[j] + bv[j])); KK[j] = k; float x = __logf(1.0f - k); \
            HF_SCAN LL[j] = x; }
        HF_ONE(a0, k0, l0) __builtin_amdgcn_sched_barrier(0); HF_ONE(a1, k1, l1) __builtin_amdgcn_sched_barrier(0); HF_ONE(a2, k2, l2) __builtin_amdgcn_sched_barrier(0); HF_ONE(a3, k3, l3) __builtin_amdgcn_sched_barrier(0);
#undef HF_ONE
        f32x4 t0, t1, t2, t3;
#pragma unroll
        for (int j = 0; j < 4; ++j) { t0[j] = HF_BC(l0[j]); t1[j] = HF_BC(l1[j]); t2[j] = HF_BC(l2[j]); t3[j] = HF_BC(l3[j]); }
        const f32x4 r = t0 + t1, bl = r + t2 + t3;
        const f32x4 b0 = l0, b1 = l1 + t0, b2 = l2 + r, b3 = l3 + r + t2;
#define HF_ST(B, KK, QQ, M) { f32x4 e, kt; _Pragma("unroll") for (int j = 0; j < 4; ++j) { e[j] = fsilu(QQ[j] + bq[j]) * __expf(B[j] - r[j]); kt[j] = KK[j] * __expf(r[j] - B[j]); } \
            pg8::u32x2 we, wk; we.x = cvt_pk_bf16(e[0], e[1]); we.y = cvt_pk_bf16(e[2], e[3]); wk.x = cvt_pk_bf16(kt[0], kt[1]); wk.y = cvt_pk_bf16(kt[2], kt[3]); \
            *(pg8::u32x2*)(uqp + (size_t)(M) * 16 * 128) = we; *(pg8::u32x2*)(ukp + (size_t)(M) * 16 * 128) = wk; }
        HF_ST(b0, k0, q0, 0) __builtin_amdgcn_sched_barrier(0); HF_ST(b1, k1, q1, 1) __builtin_amdgcn_sched_barrier(0); HF_ST(b2, k2, q2, 2) __builtin_amdgcn_sched_barrier(0); HF_ST(b3, k3, q3, 3) __builtin_amdgcn_sched_barrier(0);
#undef HF_ST
        if (fr == 0) { f32x4 er, el;
#pragma unroll
            for (int j = 0; j < 4; ++j) { er[j] = __expf(r[j]); el[j] = __expf(bl[j] - r[j]); }
            *(f32x4*)(ER + (size_t)cidx * 512 + c) = er; *(f32x4*)(EL + (size_t)cidx * 512 + c) = el; }
    }
};
struct EpiOutProj {
    static constexpr bool PERM = true;
    const bf16* X; bf16* YB; float* ST;
    __device__ __forceinline__ void operator()(const f32x4 (&acc)[2][2][4][2], const Unit& u, int wr, int wc, int fr, int fq) const {
        const int row0 = u.pm * BM + wr * 64 + fr, col0 = u.pn * BM + wc * 32 + 8 * fq;
#pragma unroll
        for (int ai = 0; ai < 2; ++ai) {
            pg8::u32x4 xw[4][2];
#pragma unroll
            for (int m = 0; m < 4; ++m)
#pragma unroll
                for (int bj = 0; bj < 2; ++bj) xw[m][bj] = *(const pg8::u32x4*)(X + (size_t)(row0 + ai * HALF + m * 16) * D + col0 + bj * HALF);
#pragma unroll
            for (int m = 0; m < 4; ++m) { const size_t row = (size_t)(row0 + ai * HALF + m * 16); const size_t off = row * D + col0; float s = 0.f, q = 0.f;
#pragma unroll
                for (int bj = 0; bj < 2; ++bj) { const pg8::u32x4 x = xw[m][bj];
                    const f32x4 x0 = {bflo(x.x), bfhi(x.x), bflo(x.y), bfhi(x.y)}, x1 = {bflo(x.z), bfhi(x.z), bflo(x.w), bfhi(x.w)};
                    const f32x4 v0 = x0 * ALPHA + acc[ai][bj][m][0], v1 = x1 * ALPHA + acc[ai][bj][m][1];
                    pg8::u32x4 w; w.x = cvt_pk_bf16(v0[0], v0[1]); w.y = cvt_pk_bf16(v0[2], v0[3]); w.z = cvt_pk_bf16(v1[0], v1[1]); w.w = cvt_pk_bf16(v1[2], v1[3]);
                    *(pg8::u32x4*)(YB + off + bj * HALF) = w;
                    s += (v0[0] + v0[1]) + (v0[2] + v0[3]) + (v1[0] + v1[1]) + (v1[2] + v1[3]);
                    q += (v0[0] * v0[0] + v0[1] * v0[1]) + (v0[2] * v0[2] + v0[3] * v0[3]) + (v1[0] * v1[0] + v1[1] * v1[1]) + (v1[2] * v1[2] + v1[3] * v1[3]); }
                s += __shfl_xor(s, 16); s += __shfl_xor(s, 32); q += __shfl_xor(q, 16); q += __shfl_xor(q, 32);
                if (fq == 0) { atomicAdd(ST + 2 * row, s); atomicAdd(ST + 2 * row + 1, q); } }
            asm volatile("" ::: "memory"); }
    }
};
struct EpiGateUp {
    static constexpr bool PERM = true;
    bf16* H; const float* ST; const float* cs; const float* bw;
    __device__ __forceinline__ void operator()(const f32x4 (&acc)[2][2][4][2], const Unit& u, int wr, int wc, int fr, int fq) const {
        const int row0 = u.pm * BM + wr * 64 + fr, cw = wc * 32 + 8 * fq;
        const int bcol = u.pn * BM + cw;
        f32x4 cg[2], cu[2], bg[2], bu[2];
#pragma unroll
        for (int n = 0; n < 2; ++n) { cg[n] = *(const f32x4*)(cs + bcol + 4 * n); cu[n] = *(const f32x4*)(cs + bcol + HALF + 4 * n); bg[n] = *(const f32x4*)(bw + bcol + 4 * n); bu[n] = *(const f32x4*)(bw + bcol + HALF + 4 * n); }
#pragma unroll
        for (int ai = 0; ai < 2; ++ai)
#pragma unroll
            for (int m = 0; m < 4; ++m) { const size_t row = (size_t)(row0 + ai * HALF + m * 16);
                const f32x2 st = *(const f32x2*)(ST + 2 * row); const float mu = st.x * (1.0f / D), var = st.y * (1.0f / D) - mu * mu, r = rsqrtf(fmaxf(var, 0.f) + LN_EPS);
                f32x4 hv[2];
#pragma unroll
                for (int n = 0; n < 2; ++n) {
#pragma unroll
                    for (int j = 0; j < 4; ++j) { const float g = r * (acc[ai][0][m][n][j] - mu * cg[n][j]) + bg[n][j]; const float up = r * (acc[ai][1][m][n][j] - mu * cu[n][j]) + bu[n][j]; hv[n][j] = fsilu(g) * up; } }
                pg8::u32x4 w; w.x = cvt_pk_bf16(hv[0][0], hv[0][1]); w.y = cvt_pk_bf16(hv[0][2], hv[0][3]); w.z = cvt_pk_bf16(hv[1][0], hv[1][1]); w.w = cvt_pk_bf16(hv[1][2], hv[1][3]);
                *(pg8::u32x4*)(H + row * FF + u.pn * HALF + cw) = w; }
    }
};
struct EpiDown {
    static constexpr bool PERM = true;
    bf16* YB; const float* ST1; float* ST2; const float* g1; const float* b1;
    __device__ __forceinline__ void operator()(const f32x4 (&acc)[2][2][4][2], const Unit& u, int wr, int wc, int fr, int fq) const {
        const int row0 = u.pm * BM + wr * 64 + fr, col0 = u.pn * BM + wc * 32 + 8 * fq;
        f32x4 gv[2][2], bv[2][2];
#pragma unroll
        for (int bj = 0; bj < 2; ++bj)
#pragma unroll
            for (int n = 0; n < 2; ++n) { gv[bj][n] = *(const f32x4*)(g1 + col0 + bj * HALF + 4 * n); bv[bj][n] = *(const f32x4*)(b1 + col0 + bj * HALF + 4 * n); }
#pragma unroll
        for (int ai = 0; ai < 2; ++ai) {
            pg8::u32x4 yw[4][2]; f32x2 st[4];
#pragma unroll
            for (int m = 0; m < 4; ++m) { const size_t row = (size_t)(row0 + ai * HALF + m * 16); st[m] = *(const f32x2*)(ST1 + 2 * row);
#pragma unroll
                for (int bj = 0; bj < 2; ++bj) yw[m][bj] = *(const pg8::u32x4*)(YB + row * D + col0 + bj * HALF); }
#pragma unroll
            for (int m = 0; m < 4; ++m) { const size_t row = (size_t)(row0 + ai * HALF + m * 16); const size_t off = row * D + col0; float s = 0.f, q = 0.f;
                const float mu = st[m].x * (1.0f / D), var = st[m].y * (1.0f / D) - mu * mu, r = rsqrtf(fmaxf(var, 0.f) + LN_EPS);
#pragma unroll
                for (int bj = 0; bj < 2; ++bj) { const pg8::u32x4 y = yw[m][bj];
                    const f32x4 y0 = {bflo(y.x), bfhi(y.x), bflo(y.y), bfhi(y.y)}, y1 = {bflo(y.z), bfhi(y.z), bflo(y.w), bfhi(y.w)};
                    const f32x4 x0 = (y0 - mu) * r * gv[bj][0] + bv[bj][0], x1 = (y1 - mu) * r * gv[bj][1] + bv[bj][1];
                    const f32x4 v0 = x0 * ALPHA + acc[ai][bj][m][0], v1 = x1 * ALPHA + acc[ai][bj][m][1];
                    pg8::u32x4 w; w.x = cvt_pk_bf16(v0[0], v0[1]); w.y = cvt_pk_bf16(v0[2], v0[3]); w.z = cvt_pk_bf16(v1[0], v1[1]); w.w = cvt_pk_bf16(v1[2], v1[3]);
                    *(pg8::u32x4*)(YB + off + bj * HALF) = w;
                    s += (v0[0] + v0[1]) + (v0[2] + v0[3]) + (v1[0] + v1[1]) + (v1[2] + v1[3]);
                    q += (v0[0] * v0[0] + v0[1] * v0[1]) + (v0[2] * v0[2] + v0[3] * v0[3]) + (v1[0] * v1[0] + v1[1] * v1[1]) + (v1[2] * v1[2] + v1[3] * v1[3]); }
                s += __shfl_xor(s, 16); s += __shfl_xor(s, 32); q += __shfl_xor(q, 16); q += __shfl_xor(q, 32);
                if (fq == 0) { atomicAdd(ST2 + 2 * row, s); atomicAdd(ST2 + 2 * row + 1, q); } }
            asm volatile("" ::: "memory"); }
    }
};
struct EpiPleP {
    static constexpr bool PERM = true;
    pg8::u32x4* SCR;
    __device__ __forceinline__ void operator()(const f32x4 (&acc)[2][2][4][2], const Unit& u, int wr, int wc, int fr, int fq) const {
        pg8::u32x4* slab = SCR + (size_t)(u.pm * 4 + u.pn) * 8192 + threadIdx.x;
#pragma unroll
        for (int ai = 0; ai < 2; ++ai)
#pragma unroll
            for (int m = 0; m < 4; ++m)
#pragma unroll
                for (int bj = 0; bj < 2; ++bj) { const f32x4 v0 = acc[ai][bj][m][0], v1 = acc[ai][bj][m][1];
                    pg8::u32x4 w; w.x = cvt_pk_bf16(v0[0], v0[1]); w.y = cvt_pk_bf16(v0[2], v0[3]); w.z = cvt_pk_bf16(v1[0], v1[1]); w.w = cvt_pk_bf16(v1[2], v1[3]);
                    slab[((ai * 4 + m) * 2 + bj) * 512] = w; }
    }
};
struct EpiFinal {
    static constexpr bool PERM = true;
    float* OUT; const bf16* YB; const pg8::u32x4* SCR; const float* ST2; const float* g2; const float* b2; const float* cs; const float* bw; const float* bgate;
    __device__ __forceinline__ void operator()(const f32x4 (&acc)[2][2][4][2], const Unit& u, int wr, int wc, int fr, int fq) const {
        const int row0 = u.pm * BM + wr * 64 + fr, col0 = u.pn * BM + wc * 32 + 8 * fq;
        const pg8::u32x4* slab = SCR + (size_t)(u.pm * 4 + u.pn) * 8192 + threadIdx.x;
        float mu[2][4], rr[2][4];
#pragma unroll
        for (int ai = 0; ai < 2; ++ai)
#pragma unroll
            for (int m = 0; m < 4; ++m) { const size_t row = (size_t)(row0 + ai * HALF + m * 16);
                const f32x2 st = *(const f32x2*)(ST2 + 2 * row); const float mean = st.x * (1.0f / D), var = st.y * (1.0f / D) - mean * mean; mu[ai][m] = mean; rr[ai][m] = rsqrtf(fmaxf(var, 0.f) + LN_EPS); }
#pragma unroll
        for (int bj = 0; bj < 2; ++bj) { const int c = col0 + bj * HALF;
            f32x4 gv[2], bv[2], cv[2], wv[2];
#pragma unroll
            for (int n = 0; n < 2; ++n) { gv[n] = *(const f32x4*)(g2 + c + 4 * n); bv[n] = *(const f32x4*)(b2 + c + 4 * n); cv[n] = *(const f32x4*)(cs + c + 4 * n); wv[n] = *(const f32x4*)(bw + c + 4 * n) + *(const f32x4*)(bgate + c + 4 * n); }
#pragma unroll
            for (int ai = 0; ai < 2; ++ai) {
#pragma unroll
                for (int m = 0; m < 4; ++m) { const size_t off = (size_t)(row0 + ai * HALF + m * 16) * D + c;
                    const pg8::u32x4 yw = *(const pg8::u32x4*)(YB + off), pw = slab[((ai * 4 + m) * 2 + bj) * 512];
                    const f32x4 y[2] = {{bflo(yw.x), bfhi(yw.x), bflo(yw.y), bfhi(yw.y)}, {bflo(yw.z), bfhi(yw.z), bflo(yw.w), bfhi(yw.w)}};
                    const f32x4 pp[2] = {{bflo(pw.x), bfhi(pw.x), bflo(pw.y), bfhi(pw.y)}, {bflo(pw.z), bfhi(pw.z), bflo(pw.w), bfhi(pw.w)}};
                    const float mean = mu[ai][m], r = rr[ai][m];
#pragma unroll
                    for (int n = 0; n < 2; ++n) { const f32x4 x2 = (y[n] - mean) * r * gv[n] + bv[n]; f32x4 o;
#pragma unroll
                        for (int j = 0; j < 4; ++j) { const float gp = r * (acc[ai][bj][m][n][j] - mean * cv[n][j]) + wv[n][j]; o[j] = x2[j] + fsigmoid(gp) * pp[n][j]; }
                        *(f32x4*)(OUT + off + 4 * n) = o; } }
                asm volatile("" ::: "memory"); } }
    }
};

struct Frame {
    LAS unsigned char* lds;
    int tid, lane, wave, vcu, G;
};

template <int MAP>
__device__ __forceinline__ void p0_transpose_item(const float* W, int K, int ldw, int nblk, bf16* WT, const float* gk, const float* bk, float* cs, float* bw, LAS float* scr, int item, int lane) {
    const int kb = item / nblk, nb = item % nblk, k0 = 64 * kb, n0 = 32 * nb;
#pragma unroll 8
    for (int i = 0; i < 32; ++i) { const int kk = 2 * i + (lane >> 5); scr[kk * 33 + (lane & 31)] = W[(size_t)(k0 + kk) * ldw + n0 + (lane & 31)]; }
    LDS_WAIT(); asm volatile("" ::: "memory");
    const int c = lane & 7;
    float gs[8], bs[8];
#pragma unroll
    for (int e = 0; e < 8; ++e) { gs[e] = gk ? gk[k0 + 8 * c + e] : 1.0f; bs[e] = bk ? bk[k0 + 8 * c + e] : 0.0f; }
#pragma unroll
    for (int j = 0; j < 4; ++j) { const int n = (lane >> 3) + 8 * j; const LAS float* s = scr + (8 * c) * 33 + n;
        float w[8]; float sb = 0.f;
#pragma unroll
        for (int e = 0; e < 8; ++e) { const float raw = s[e * 33]; sb += bs[e] * raw; w[e] = raw * gs[e]; }
        v4u o; o.x = pk2(w[0], w[1]); o.y = pk2(w[2], w[3]); o.z = pk2(w[4], w[5]); o.w = pk2(w[6], w[7]);
        const int ng = n0 + n;
        const int row = (MAP == 0) ? ng : (MAP == 3) ? ((ng < 512) ? ((ng >> 7) * 256 + (ng & 127)) : (ng < 1024) ? (((ng - 512) >> 7) * 256 + 128 + (ng & 127)) : ng)
                                     : ((ng >> 7) * 256 + (ng & 127) + (MAP == 2 ? 128 : 0));
        *(GAS v4u*)(WT + (size_t)row * K + k0 + 8 * c) = o;
        if (cs) {
            float sc = (bflo(o.x) + bfhi(o.x)) + (bflo(o.y) + bfhi(o.y)) + (bflo(o.z) + bfhi(o.z)) + (bflo(o.w) + bfhi(o.w));
            sc += __shfl_xor(sc, 1); sc += __shfl_xor(sc, 2); sc += __shfl_xor(sc, 4);
            sb += __shfl_xor(sb, 1); sb += __shfl_xor(sb, 2); sb += __shfl_xor(sb, 4);
            if (c == 0) { atomicAdd(cs + row, sc); atomicAdd(bw + row, sb); }
        } }
    LDS_WAIT(); asm volatile("" ::: "memory");
}

struct Args { const float* in[20]; float* out; unsigned char* ws; int ph_lo, ph_hi, flags, pad; };

__device__ __forceinline__ void p0_prologue(const Frame& F, const Args& a) {
    unsigned char* ws = a.ws;
    LAS float* scr = (LAS float*)(F.lds + RING_OFF + F.wave * 16384);
    const int gw = F.vcu * NWAVES + F.wave, NGW = F.G * NWAVES;
    const float* w_in = a.in[2]; const float* w_out = a.in[9]; const float* wg = a.in[12]; const float* wu = a.in[13]; const float* wd = a.in[14]; const float* wpp = a.in[17]; const float* wpg = a.in[18];
    const float* ln1_g = a.in[10]; const float* ln1_b = a.in[11]; const float* ln2_g = a.in[15]; const float* ln2_b = a.in[16];
    float* cs_gu = (float*)(ws + WS_CTL + CTL_CS_GU); float* bw_gu = (float*)(ws + WS_CTL + CTL_BW_GU); float* cs_pg = (float*)(ws + WS_CTL + CTL_CS_PG); float* bw_pg = (float*)(ws + WS_CTL + CTL_BW_PG);
    constexpr int I_IN = (D / 64) * (NIN / 32), I_OUT = (D / 64) * (D / 32), I_G = (D / 64) * (FF / 32), I_DN = (FF / 64) * (D / 32), I_PG = I_OUT, I_PP = (PLE / 64) * (D / 32);
    constexpr int NITEMS = I_IN + I_OUT + 2 * I_G + I_DN + I_PG + I_PP;
    for (int it = gw; it < NITEMS; it += NGW) {
        int r = it;
        if (r < I_IN) { p0_transpose_item<3>(w_in, D, PROJW, NIN / 32, (bf16*)(ws + WS_WIN), nullptr, nullptr, nullptr, nullptr, scr, r, F.lane); continue; } r -= I_IN;
        if (r < I_OUT) { p0_transpose_item<0>(w_out, D, D, D / 32, (bf16*)(ws + WS_WOUT), nullptr, nullptr, nullptr, nullptr, scr, r, F.lane); continue; } r -= I_OUT;
        if (r < I_G) { p0_transpose_item<1>(wg, D, FF, FF / 32, (bf16*)(ws + WS_WGU), ln1_g, ln1_b, cs_gu, bw_gu, scr, r, F.lane); continue; } r -= I_G;
        if (r < I_G) { p0_transpose_item<2>(wu, D, FF, FF / 32, (bf16*)(ws + WS_WGU), ln1_g, ln1_b, cs_gu, bw_gu, scr, r, F.lane); continue; } r -= I_G;
        if (r < I_DN) { p0_transpose_item<0>(wd, FF, D, D / 32, (bf16*)(ws + WS_WDN), nullptr, nullptr, nullptr, nullptr, scr, r, F.lane); continue; } r -= I_DN;
        if (r < I_PG) { p0_transpose_item<0>(wpg, D, D, D / 32, (bf16*)(ws + WS_WPG), ln2_g, ln2_b, cs_pg, bw_pg, scr, r, F.lane); continue; } r -= I_PG;
        p0_transpose_item<0>(wpp, PLE, D, D / 32, (bf16*)(ws + WS_WPP), nullptr, nullptr, nullptr, nullptr, scr, r, F.lane);
    }
    if (gw == 0) { const float* lg = a.in[4]; float* oml = (float*)(ws + WS_OML);
        for (int c = F.lane; c < 512; c += 64) { const float l0 = lg[c], l1 = lg[512 + c]; const float mx = fmaxf(l0, l1); const float e0 = __expf(l0 - mx), e1 = __expf(l1 - mx); oml[c] = e1 / (e0 + e1); } }
    {
        const float* x = a.in[0]; const float* p = a.in[1]; const float* b_in = a.in[3];
        bf16* XB = (bf16*)(ws + WS_XB); bf16* PB = (bf16*)(ws + WS_PB); float* GATES = (float*)(ws + WS_GATES);
        f32x4 wl[2][8][2];
#pragma unroll
        for (int j = 0; j < 2; ++j)
#pragma unroll
            for (int e = 0; e < 8; ++e) { const float* wp = w_in + (size_t)(8 * F.lane + 512 * j + e) * PROJW + NIN; wl[j][e][0] = *(const f32x4*)wp; wl[j][e][1] = *(const f32x4*)(wp + 4); }
        const float bsel = b_in[NIN + (F.lane >> 3)];
        f32x4 na[2][2], npv;
        { const int m0 = gw < M ? gw : 0; const float* xr = x + (size_t)m0 * D;
#pragma unroll
          for (int j = 0; j < 2; ++j) { na[j][0] = *(const f32x4*)(xr + 8 * F.lane + 512 * j); na[j][1] = *(const f32x4*)(xr + 8 * F.lane + 512 * j + 4); }
          npv = *(const f32x4*)(p + (size_t)m0 * PLE + 4 * F.lane); }
        for (int m = gw; m < M; m += NGW) {
            f32x4 ca[2][2]; const f32x4 pv = npv;
#pragma unroll
            for (int j = 0; j < 2; ++j) { ca[j][0] = na[j][0]; ca[j][1] = na[j][1]; }
            { const int mn = (m + NGW < M) ? (m + NGW) : m; const float* xr = x + (size_t)mn * D;
#pragma unroll
              for (int j = 0; j < 2; ++j) { na[j][0] = *(const f32x4*)(xr + 8 * F.lane + 512 * j); na[j][1] = *(const f32x4*)(xr + 8 * F.lane + 512 * j + 4); }
              npv = *(const f32x4*)(p + (size_t)mn * PLE + 4 * F.lane); }
            f32x4 g0 = {0.f, 0.f, 0.f, 0.f}, g1 = {0.f, 0.f, 0.f, 0.f};
#pragma unroll
            for (int j = 0; j < 2; ++j) { const f32x4 a0 = ca[j][0], a1 = ca[j][1];
                v4u o; o.x = pk2(a0[0], a0[1]); o.y = pk2(a0[2], a0[3]); o.z = pk2(a1[0], a1[1]); o.w = pk2(a1[2], a1[3]);
                *(GAS v4u*)(XB + (size_t)m * D + 8 * F.lane + 512 * j) = o;
#pragma unroll
                for (int e = 0; e < 4; ++e) { g0 += wl[j][e][0] * a0[e]; g1 += wl[j][e][1] * a0[e]; g0 += wl[j][4 + e][0] * a1[e]; g1 += wl[j][4 + e][1] * a1[e]; } }
            const bool b5 = (F.lane & 32) != 0, b4 = (F.lane & 16) != 0, b3 = (F.lane & 8) != 0;
            float k4[4];
#pragma unroll
            for (int e = 0; e < 4; ++e) { const float keep = b5 ? g1[e] : g0[e], send = b5 ? g0[e] : g1[e]; k4[e] = keep + __shfl_xor(send, 32); }
            float k2[2];
#pragma unroll
            for (int e = 0; e < 2; ++e) { const float keep = b4 ? k4[2 + e] : k4[e], send = b4 ? k4[e] : k4[2 + e]; k2[e] = keep + __shfl_xor(send, 16); }
            float k1; { const float keep = b3 ? k2[1] : k2[0], send = b3 ? k2[0] : k2[1]; k1 = keep + __shfl_xor(send, 8); }
            k1 += __shfl_xor(k1, 4); k1 += __shfl_xor(k1, 2); k1 += __shfl_xor(k1, 1);
            if ((F.lane & 7) == 0) GATES[(size_t)m * 8 + (F.lane >> 3)] = k1 + bsel;
            v2u po; po.x = pk2(pv[0], pv[1]); po.y = pk2(pv[2], pv[3]);
            *(GAS v2u*)(PB + (size_t)m * PLE + 4 * F.lane) = po;
        }
    }
}

namespace mx {
typedef short s16x4 __attribute__((ext_vector_type(4)));
typedef short bf16x8 __attribute__((ext_vector_type(8)));
typedef short v4i16_t __attribute__((ext_vector_type(4)));
constexpr int NCH = 8;
constexpr int NSC = SEQ / (64 * NCH);
constexpr int NUNIT = 16 * NSC;
constexpr int L_QT = 0, L_KT = 16384, L_V = 32768, L_G = 49152, L_IMG = 65536  , L_XT = 131072, L_PART = 140288  ;
constexpr int XT_STRIDE = 144;
__device__ __forceinline__ unsigned off_b(unsigned row, unsigned ch) { return 256u * row + 16u * (ch ^ (((row & 3) << 2) | ((row >> 2) & 3))); }
__device__ __forceinline__ unsigned row_addr16(unsigned lane, unsigned rb, unsigned s) { return off_b((lane & 15) + 16 * rb, 4 * s + (lane >> 4)); }
__device__ __forceinline__ unsigned tr_addr16(unsigned lane, unsigned c, unsigned ks, unsigned t) { const unsigned g = lane >> 4, q = (lane & 15) >> 2, p = lane & 3;
    return off_b(32 * ks + 8 * g + 4 * t + q, 2 * c + (p >> 1)) + 8 * (p & 1); }
__device__ __forceinline__ unsigned perm_addr16(unsigned lane, unsigned rb, unsigned ks, unsigned half) { const unsigned g = lane >> 4;
    return off_b((lane & 15) + 16 * rb, 4 * ks + 2 * half + (g >> 1)) + 8 * (g & 1); }
__device__ __forceinline__ bf16x8 ld128(LAS unsigned char* L, unsigned off) { return *(const LAS bf16x8*)(L + off); }
__device__ __forceinline__ s16x4 ld64(LAS unsigned char* L, unsigned off) { return *(const LAS s16x4*)(L + off); }
__device__ __forceinline__ s16x4 ldtr(LAS unsigned char* L, unsigned off) { return __builtin_bit_cast(s16x4, __builtin_amdgcn_ds_read_tr16_b64_v4i16((LAS v4i16_t*)(L + off))); }
using pg8::cvt_pk_bf16;
__device__ __forceinline__ bf16x8 cat(s16x4 lo, s16x4 hi) { return (bf16x8){lo[0], lo[1], lo[2], lo[3], hi[0], hi[1], hi[2], hi[3]}; }
__device__ __forceinline__ bf16x8 pack8(const f32x4& a, const f32x4& b) { v4u w; w.x = cvt_pk_bf16(a[0], a[1]); w.y = cvt_pk_bf16(a[2], a[3]); w.z = cvt_pk_bf16(b[0], b[1]); w.w = cvt_pk_bf16(b[2], b[3]); return __builtin_bit_cast(bf16x8, w); }
#define MX_MFMA(a, b, c) __builtin_amdgcn_mfma_f32_16x16x32_bf16((a), (b), (c), 0, 0, 0)

template <int NKS>
__device__ __forceinline__ void x_tile(LAS unsigned char* L, LAS unsigned char* I, int lane, int sb, int tb) {
    f32x4 x = {0.f, 0.f, 0.f, 0.f};
#pragma unroll
    for (int ks = 0; ks < NKS; ++ks) x = MX_MFMA(ld128(I + L_KT, row_addr16(lane, sb, ks)), ld128(I + L_QT, row_addr16(lane, tb, ks)), x);
    const int g = lane >> 4, l15 = lane & 15;
#ifdef DBG_T5
    x = (f32x4){1.f, 1.f, 1.f, 1.f};
#endif
    if (sb == tb) {
#pragma unroll
        for (int i = 0; i < 4; ++i) x[i] = (4 * g + i <= l15) ? x[i] : 0.f;
    }
    v2u w; w.x = cvt_pk_bf16(x[0], x[1]); w.y = cvt_pk_bf16(x[2], x[3]);
    *(LAS v2u*)(L + L_XT + (16 * tb + l15) * XT_STRIDE + (16 * sb + 4 * g) * 2) = w;
}
template <int NKS>
__device__ __forceinline__ void x_all(LAS unsigned char* L, LAS unsigned char* I, int lane, int w) {
    switch (w) {
        case 0: x_tile<NKS>(L, I, lane, 0, 0); x_tile<NKS>(L, I, lane, 2, 3); break;
        case 1: x_tile<NKS>(L, I, lane, 0, 1); x_tile<NKS>(L, I, lane, 3, 3); break;
        case 2: x_tile<NKS>(L, I, lane, 1, 1); break;
        case 3: x_tile<NKS>(L, I, lane, 0, 2); break;
        case 4: x_tile<NKS>(L, I, lane, 1, 2); break;
        case 5: x_tile<NKS>(L, I, lane, 2, 2); break;
        case 6: x_tile<NKS>(L, I, lane, 0, 3); break;
        default: x_tile<NKS>(L, I, lane, 1, 3); break;
    }
}
__device__ __forceinline__ void x_zero(LAS unsigned char* L, int tid) {
    if (tid < 128) { const int which = tid >> 6, e = tid & 63, t = (which ? 32 : 0) + (e >> 2), s = (which ? 48 : 16) + 4 * (e & 3);
        v2u z; z.x = 0u; z.y = 0u; *(LAS v2u*)(L + L_XT + t * XT_STRIDE + s * 2) = z; }
}
__device__ __forceinline__ void out_store(bf16* orow, const f32x4 (&O)[4], const float (&scale)[4], const f32x4& gn, const v2u (&gw)[4]) {
#pragma unroll
    for (int tb = 0; tb < 4; ++tb) { const float r = scale[tb];
        v2u ww; ww.x = cvt_pk_bf16(O[tb][0] * r * gn[0] * bflo(gw[tb].x), O[tb][1] * r * gn[1] * bfhi(gw[tb].x)); ww.y = cvt_pk_bf16(O[tb][2] * r * gn[2] * bflo(gw[tb].y), O[tb][3] * r * gn[3] * bfhi(gw[tb].y));
        *(GAS v2u*)(orow + (size_t)(16 * tb) * D) = ww; }
}
#define MX_BAR() do { asm volatile("s_waitcnt lgkmcnt(0)" ::: "memory"); __builtin_amdgcn_s_barrier(); asm volatile("" ::: "memory"); } while (0)
constexpr int L_ERL = 144384;
constexpr int L_CW = 146432;
constexpr int L_GT = 148992;
constexpr int L_DEN = 153344;
constexpr int L_NST = 153856;

template <bool FULL>
__device__ __forceinline__ void hg_unit(const Frame& F, const Args& a, int uid) {
    unsigned char* ws = a.ws; LAS unsigned char* L = F.lds;
    const int tid = F.tid, w = F.wave;
    const int b = uid / (4 * NSC), h = (uid / NSC) & 3, sc = uid % NSC;
    const size_t row0 = (size_t)b * SEQ + (size_t)sc * (64 * NCH);
    const bf16* UQ = (const bf16*)(ws + WS_U + UO_Q) + (size_t)h * M * 128; const bf16* UK = (const bf16*)(ws + WS_U + UO_K) + (size_t)h * M * 128;
    const bf16* UV = (const bf16*)(ws + WS_U + UO_V) + (size_t)h * M * 128; const bf16* UG = (const bf16*)(ws + WS_U + UO_G) + (size_t)h * M * 128; const bf16* EQ = (const bf16*)(ws + WS_LOGF) + (size_t)h * M * 128;
    const float* ER = (const float*)(ws + WS_ER); const float* EL = (const float*)(ws + WS_EL);
    float* SST = (float*)(ws + (FULL ? WS_HGI : WS_HGS)) + (size_t)uid * 16384;
    bf16* OB = (bf16*)a.out;
    const int prow0 = tid >> 4, pch = tid & 15, prow1 = prow0 + 32;
    v4u rk[2], rv[2], rq[2], rg[2]; float rer = 0.f;
#define HG_LOAD(c) do { const size_t rowc_ = row0 + 64 * (c); \
        _Pragma("unroll") for (int i2 = 0; i2 < 2; ++i2) { const size_t eo = (rowc_ + (i2 ? prow1 : prow0)) * 128 + 8 * pch; \
            rk[i2] = *(const GAS v4u*)(UK + eo); rv[i2] = *(const GAS v4u*)(UV + eo); \
            if (FULL) { rq[i2] = *(const GAS v4u*)(UQ + eo); rg[i2] = *(const GAS v4u*)(UG + eo); } } \
        if (tid < 256) rer = ((tid < 128) ? ER : EL)[(rowc_ >> 6) * 512 + h * 128 + (tid & 127)]; } while (0)
    HG_LOAD(0);
    f32x4 S[8];
    { const int lane = F.lane;
#pragma unroll
      for (int db = 0; db < 8; ++db) S[db] = FULL ? *(const f32x4*)(SST + ((w * 8 + db) * 64 + lane) * 4) : (f32x4){0.f, 0.f, 0.f, 0.f}; }
    f32x4 gn = {0.f, 0.f, 0.f, 0.f};
    if (FULL) { gn = *(const f32x4*)(a.in[7] + h * 128 + 16 * w + 4 * (F.lane >> 4)); x_zero(L, tid); }
    asm volatile("" : "+v"(gn));
#define HG_WRITE(P) do { LAS unsigned char* I_ = L + (P) * L_IMG; \
        _Pragma("unroll") for (int i2 = 0; i2 < 2; ++i2) { const unsigned o = off_b(i2 ? prow1 : prow0, pch); \
            *(LAS v4u*)(I_ + L_KT + o) = rk[i2]; *(LAS v4u*)(I_ + L_V + o) = rv[i2]; \
            if (FULL) { *(LAS v4u*)(I_ + L_G + o) = rg[i2]; *(LAS v4u*)(I_ + L_QT + o) = rq[i2]; } } \
        if (tid < 256) *(LAS float*)(L + L_ERL + (P) * 1024 + tid * 4) = rer; } while (0)
    HG_WRITE(0); HG_LOAD(1);
    MX_BAR();
    for (int c = 0; c < NCH; ++c) {
        const size_t rowc = row0 + 64 * c; const int p = c & 1;
        int lane = F.lane; asm volatile("" : "+v"(lane));
        const int g = lane >> 4, l15 = lane & 15;
        LAS unsigned char* I = L + p * L_IMG; LAS unsigned char* E = L + L_ERL + p * 1024;
        if (FULL) x_all<4>(L, I, lane, w);
        __builtin_amdgcn_sched_barrier(0);
        if (c < NCH - 1) { HG_WRITE(p ^ 1); if (c < NCH - 2) HG_LOAD(c + 2); }
        __builtin_amdgcn_sched_barrier(0);
#pragma unroll
        for (int db = 0; db < 8; ++db) S[db] *= *(const LAS f32x4*)(E + (16 * db + 4 * g) * 4);
        s16x4 vlo[2], vhi[2];
#pragma unroll
        for (int ks = 0; ks < 2; ++ks) { vlo[ks] = ldtr(I + L_V, tr_addr16(lane, w, ks, 0)); vhi[ks] = ldtr(I + L_V, tr_addr16(lane, w, ks, 1)); }
        f32x4 O[4];
        if (FULL) {
#pragma unroll
            for (int tb = 0; tb < 4; ++tb) O[tb] = (f32x4){0.f, 0.f, 0.f, 0.f};
#pragma unroll
            for (int ks = 0; ks < 4; ++ks) { const bf16x8 sa = pack8(S[2 * ks], S[2 * ks + 1]);
#pragma unroll
                for (int tb = 0; tb < 4; ++tb) O[tb] = MX_MFMA(sa, cat(ld64(I + L_QT, perm_addr16(lane, tb, ks, 0)), ld64(I + L_QT, perm_addr16(lane, tb, ks, 1))), O[tb]); }
        }
#pragma unroll
        for (int db = 0; db < 8; ++db) {
#pragma unroll
            for (int ks = 0; ks < 2; ++ks) S[db] = MX_MFMA(cat(ldtr(I + L_KT, tr_addr16(lane, db, ks, 0)), ldtr(I + L_KT, tr_addr16(lane, db, ks, 1))), cat(vlo[ks], vhi[ks]), S[db]);
            S[db] *= *(const LAS f32x4*)(E + (128 + 16 * db + 4 * g) * 4); }
        MX_BAR();
        if (FULL) {
            v2u gw[4];
#pragma unroll
            for (int tb = 0; tb < 4; ++tb) gw[tb] = *(const LAS v2u*)(I + L_G + off_b(16 * tb + l15, 2 * w + (g >> 1)) + 8 * (g & 1));
#pragma unroll
            for (int tb = 0; tb < 4; ++tb)
#pragma unroll
                for (int ks = 0; ks < 2; ++ks) if (ks <= (tb >> 1))
                    O[tb] = MX_MFMA(cat(vlo[ks], vhi[ks]), *(const LAS bf16x8*)(L + L_XT + (16 * tb + l15) * XT_STRIDE + (32 * ks + 8 * g) * 2), O[tb]);
#pragma unroll
            for (int tb = 0; tb < 4; ++tb) { float ss = (O[tb][0] * O[tb][0] + O[tb][1] * O[tb][1]) + (O[tb][2] * O[tb][2] + O[tb][3] * O[tb][3]);
                ss += __shfl_xor(ss, 16); ss += __shfl_xor(ss, 32);
                if (g == 0) *(LAS float*)(L + L_PART + (p * 512 + w * 64 + 16 * tb + l15) * 4) = ss; }
            MX_BAR();
            float scale[4];
#pragma unroll
            for (int tb = 0; tb < 4; ++tb) { float tot = 0.f;
#pragma unroll
                for (int ww = 0; ww < 8; ++ww) tot += *(const LAS float*)(L + L_PART + (p * 512 + ww * 64 + 16 * tb + l15) * 4);
                scale[tb] = rsqrtf(tot * (1.0f / 128.0f) + RMS_EPS); }
            out_store(OB + (rowc + l15) * D + h * 128 + 16 * w + 4 * g, O, scale, gn, gw);
        }
    }
#undef HG_WRITE
#undef HG_LOAD
    if (!FULL) {
        const int lane = F.lane;
#pragma unroll
        for (int db = 0; db < 8; ++db) *(f32x4*)(SST + ((w * 8 + db) * 64 + lane) * 4) = S[db];
        if (tid < 128) { float pr = 1.f;
            for (int c = 0; c < NCH; ++c) { const size_t cidx = (row0 >> 6) + c; pr *= ER[cidx * 512 + h * 128 + tid] * EL[cidx * 512 + h * 128 + tid]; }
            ((float*)(ws + WS_ASC))[(size_t)uid * 128 + tid] = pr; }
    }
    MX_BAR();
}

template <bool FULL>
__device__ __forceinline__ void ml_unit(const Frame& F, const Args& a, int uid) {
    unsigned char* ws = a.ws; LAS unsigned char* L = F.lds;
    const int tid = F.tid, w = F.wave;
    const int b = uid / (4 * NSC), h = (uid / NSC) & 3, sc = uid % NSC;
    const size_t row0 = (size_t)b * SEQ + (size_t)sc * (64 * NCH);
    const bf16* MQ = (const bf16*)(ws + WS_U + UO_MQ) + (size_t)h * M * 64; const bf16* MK = (const bf16*)(ws + WS_U + UO_MK) + (size_t)h * M * 64;
    const bf16* MV = (const bf16*)(ws + WS_U + UO_MV) + (size_t)h * M * 128; const bf16* MO = (const bf16*)(ws + WS_U + UO_MO) + (size_t)h * M * 128; const float* GATES = (const float*)(ws + WS_GATES);
    float* SST = (float*)(ws + (FULL ? WS_MLCI : WS_MLC)) + (size_t)uid * 8192;
    float* MLS = (float*)(ws + WS_MLS) + (size_t)uid * 4; float* MLN = (float*)(ws + (FULL ? WS_MLNI : WS_MLN)) + (size_t)uid * 64;
    bf16* OB = (bf16*)a.out;
    LAS float* GT = (LAS float*)(L + L_GT); LAS float* CW = (LAS float*)(L + L_CW); LAS float* DEN = (LAS float*)(L + L_DEN); LAS float* NST = (LAS float*)(L + L_NST);
    const int crow = tid >> 3, cch = tid & 7;
    const int prow0 = tid >> 4, pch = tid & 15, prow1 = prow0 + 32;
    v4u xk[4], xq[4], rv[2], rg[2];
#define ML_LOAD(c) do { const long tseq0_ = (long)sc * (64 * NCH) + 64 * (c) + crow - 3; \
        _Pragma("unroll") for (int k = 0; k < 4; ++k) { const long ts = tseq0_ + k; xk[k] = (v4u){0u, 0u, 0u, 0u}; xq[k] = (v4u){0u, 0u, 0u, 0u}; \
            if (ts >= 0) { const size_t eo = ((size_t)b * SEQ + ts) * 64 + 8 * cch; xk[k] = *(const GAS v4u*)(MK + eo); if (FULL) xq[k] = *(const GAS v4u*)(MQ + eo); } } \
        _Pragma("unroll") for (int i2 = 0; i2 < 2; ++i2) { const size_t eo = (row0 + 64 * (c) + (i2 ? prow1 : prow0)) * 128 + 8 * pch; rv[i2] = *(const GAS v4u*)(MV + eo); if (FULL) rg[i2] = *(const GAS v4u*)(MO + eo); } } while (0)
    ML_LOAD(0);
    f32x4 S[4];
    { const int lane = F.lane;
#pragma unroll
      for (int db = 0; db < 4; ++db) S[db] = FULL ? *(const f32x4*)(SST + ((w * 4 + db) * 64 + lane) * 4) : (f32x4){0.f, 0.f, 0.f, 0.f}; }
    if (tid < 64) NST[tid] = FULL ? MLN[tid] : 0.f;
    if (tid >= 64 && tid < 192) { const int cc = tid - 64; const float* cw = a.in[5]; const float* cb = a.in[6]; const int gc = (cc < 64) ? (h * 64 + cc) : (256 + h * 64 + cc - 64);
#pragma unroll
        for (int k = 0; k < 4; ++k) CW[k * 128 + cc] = cw[k * 512 + gc];
        CW[512 + cc] = cb[gc]; }
    f32x4 gn = {0.f, 0.f, 0.f, 0.f};
    if (FULL) { gn = *(const f32x4*)(a.in[8] + h * 128 + 16 * w + 4 * (F.lane >> 4)); x_zero(L, tid); }
    asm volatile("" : "+v"(gn));
    if (w == 7) { const int lane = F.lane;
        float m_run = FULL ? ((const float*)(ws + WS_MLI))[uid] : -1.0e30f, gsum = 0.f;
        float igv[NCH], fgv[NCH];
#pragma unroll
        for (int c = 0; c < NCH; ++c) { igv[c] = GATES[(row0 + 64 * c + lane) * 8 + h]; fgv[c] = GATES[(row0 + 64 * c + lane) * 8 + 4 + h]; }
#pragma unroll
        for (int c = 0; c < NCH; ++c) {
            const float ig = igv[c], fgp = fgv[c];
            float gc = fminf(fgp, 0.f) - __logf(1.0f + __expf(-fabsf(fgp)));
#define ML_DPPF(x, old, ctrl, rmask, bc) __builtin_bit_cast(float, __builtin_amdgcn_update_dpp(__builtin_bit_cast(int, (old)), __builtin_bit_cast(int, (x)), (ctrl), (rmask), 0xF, (bc)))
            gc += ML_DPPF(gc, 0.f, 0x111, 0xF, true); gc += ML_DPPF(gc, 0.f, 0x112, 0xF, true); gc += ML_DPPF(gc, 0.f, 0x114, 0xF, true); gc += ML_DPPF(gc, 0.f, 0x118, 0xF, true);
            gc += ML_DPPF(gc, 0.f, 0x142, 0xA, false); gc += ML_DPPF(gc, 0.f, 0x143, 0xC, false);
            const float av = ig - gc; float amax = av;
            amax = fmaxf(amax, ML_DPPF(amax, amax, 0x111, 0xF, false)); amax = fmaxf(amax, ML_DPPF(amax, amax, 0x112, 0xF, false)); amax = fmaxf(amax, ML_DPPF(amax, amax, 0x114, 0xF, false)); amax = fmaxf(amax, ML_DPPF(amax, amax, 0x118, 0xF, false));
            amax = fmaxf(amax, ML_DPPF(amax, amax, 0x142, 0xA, false)); amax = fmaxf(amax, ML_DPPF(amax, amax, 0x143, 0xC, false));
            amax = __builtin_bit_cast(float, __builtin_amdgcn_readlane(__builtin_bit_cast(int, amax), 63));
#undef ML_DPPF
            const float mu = fmaxf(m_run, amax);
            GT[c * 128 + lane] = __expf(av - mu); GT[c * 128 + 64 + lane] = __expf(-(gc + mu));
            const float gl = __builtin_bit_cast(float, __builtin_amdgcn_readlane(__builtin_bit_cast(int, gc), 63));
            if (lane == 0) { GT[NCH * 128 + 4 * c] = __expf(m_run - mu); }
            m_run = gl + mu; gsum += gl; }
        if (lane == 0) { GT[NCH * 132] = m_run; GT[NCH * 132 + 1] = gsum; } }
    MX_BAR();
#define ML_WRITE(P, CC) do { LAS unsigned char* I_ = L + (P) * L_IMG; \
        const LAS float* cq = CW + 8 * cch; const LAS float* ck = CW + 64 + 8 * cch; \
        const unsigned o = off_b(crow, cch); \
        { f32x4 kacc0 = *(const LAS f32x4*)(ck + 512), kacc1 = *(const LAS f32x4*)(ck + 516); \
          _Pragma("unroll") for (int k = 0; k < 4; ++k) { const f32x4 wk0 = *(const LAS f32x4*)(ck + 128 * k), wk1 = *(const LAS f32x4*)(ck + 128 * k + 4); \
            kacc0[0] += wk0[0] * bflo(xk[k].x); kacc0[1] += wk0[1] * bfhi(xk[k].x); kacc0[2] += wk0[2] * bflo(xk[k].y); kacc0[3] += wk0[3] * bfhi(xk[k].y); \
            kacc1[0] += wk1[0] * bflo(xk[k].z); kacc1[1] += wk1[1] * bfhi(xk[k].z); kacc1[2] += wk1[2] * bflo(xk[k].w); kacc1[3] += wk1[3] * bfhi(xk[k].w); } \
          const float scl = GT[(CC) * 128 + crow]; \
          _Pragma("unroll") for (int e = 0; e < 4; ++e) { kacc0[e] = fsilu(kacc0[e]) * scl; kacc1[e] = fsilu(kacc1[e]) * scl; } \
          *(LAS bf16x8*)(I_ + L_KT + o) = pack8(kacc0, kacc1); } \
        __builtin_amdgcn_sched_barrier(0); \
        if (FULL) { f32x4 qacc0 = *(const LAS f32x4*)(cq + 512), qacc1 = *(const LAS f32x4*)(cq + 516); \
          _Pragma("unroll") for (int k = 0; k < 4; ++k) { const f32x4 wq0 = *(const LAS f32x4*)(cq + 128 * k), wq1 = *(const LAS f32x4*)(cq + 128 * k + 4); \
            qacc0[0] += wq0[0] * bflo(xq[k].x); qacc0[1] += wq0[1] * bfhi(xq[k].x); qacc0[2] += wq0[2] * bflo(xq[k].y); qacc0[3] += wq0[3] * bfhi(xq[k].y); \
            qacc1[0] += wq1[0] * bflo(xq[k].z); qacc1[1] += wq1[1] * bfhi(xq[k].z); qacc1[2] += wq1[2] * bflo(xq[k].w); qacc1[3] += wq1[3] * bfhi(xq[k].w); } \
          _Pragma("unroll") for (int e = 0; e < 4; ++e) { qacc0[e] = fsilu(qacc0[e]) * 0.125f; qacc1[e] = fsilu(qacc1[e]) * 0.125f; } \
          *(LAS bf16x8*)(I_ + L_QT + o) = pack8(qacc0, qacc1); } \
        __builtin_amdgcn_sched_barrier(0); \
        _Pragma("unroll") for (int i2 = 0; i2 < 2; ++i2) { const unsigned o2 = off_b(i2 ? prow1 : prow0, pch); *(LAS v4u*)(I_ + L_V + o2) = rv[i2]; if (FULL) *(LAS v4u*)(I_ + L_G + o2) = rg[i2]; } } while (0)
    ML_WRITE(0, 0); ML_LOAD(1);
    MX_BAR();
    for (int c = 0; c < NCH; ++c) {
        const size_t rowc = row0 + 64 * c; const int p = c & 1;
        int lane = F.lane; asm volatile("" : "+v"(lane));
        const int g = lane >> 4, l15 = lane & 15;
        LAS unsigned char* I = L + p * L_IMG;
        const float wv = GT[NCH * 128 + 4 * c];
        if (FULL) x_all<2>(L, I, lane, w);
        __builtin_amdgcn_sched_barrier(0);
        if (c < NCH - 1) { ML_WRITE(p ^ 1, c + 1); if (c < NCH - 2) ML_LOAD(c + 2); }
        __builtin_amdgcn_sched_barrier(0);
#pragma unroll
        for (int db = 0; db < 4; ++db) S[db] *= wv;
        s16x4 vlo[2], vhi[2];
#pragma unroll
        for (int ks = 0; ks < 2; ++ks) { vlo[ks] = ldtr(I + L_V, tr_addr16(lane, w, ks, 0)); vhi[ks] = ldtr(I + L_V, tr_addr16(lane, w, ks, 1)); }
        __builtin_amdgcn_sched_barrier(0);
        f32x4 O[4];
        if (FULL) {
#pragma unroll
            for (int tb = 0; tb < 4; ++tb) O[tb] = (f32x4){0.f, 0.f, 0.f, 0.f};
#pragma unroll
            for (int ks = 0; ks < 2; ++ks) { const bf16x8 sa = pack8(S[2 * ks], S[2 * ks + 1]);
#pragma unroll
                for (int tb = 0; tb < 4; ++tb) O[tb] = MX_MFMA(sa, cat(ld64(I + L_QT, perm_addr16(lane, tb, ks, 0)), ld64(I + L_QT, perm_addr16(lane, tb, ks, 1))), O[tb]); }
        }
        __builtin_amdgcn_sched_barrier(0);
#pragma unroll
        for (int db = 0; db < 4; ++db)
#pragma unroll
            for (int ks = 0; ks < 2; ++ks) S[db] = MX_MFMA(cat(ldtr(I + L_KT, tr_addr16(lane, db, ks, 0)), ldtr(I + L_KT, tr_addr16(lane, db, ks, 1))), cat(vlo[ks], vhi[ks]), S[db]);
        __builtin_amdgcn_sched_barrier(0);
        if (w == 1) { const int rg = lane >> 3, ch = lane & 7; float cs[8] = {0.f, 0.f, 0.f, 0.f, 0.f, 0.f, 0.f, 0.f};
#pragma unroll
            for (int r8 = 0; r8 < 8; ++r8) { const v4u kv = *(const LAS v4u*)(I + L_KT + off_b(8 * rg + r8, ch));
                cs[0] += bflo(kv.x); cs[1] += bfhi(kv.x); cs[2] += bflo(kv.y); cs[3] += bfhi(kv.y); cs[4] += bflo(kv.z); cs[5] += bfhi(kv.z); cs[6] += bflo(kv.w); cs[7] += bfhi(kv.w); }
#pragma unroll
            for (int e = 0; e < 8; ++e) { cs[e] += __shfl_xor(cs[e], 8); cs[e] += __shfl_xor(cs[e], 16); cs[e] += __shfl_xor(cs[e], 32); }
            if (lane < 8) {
#pragma unroll
                for (int e = 0; e < 8; ++e) NST[(p ^ 1) * 64 + 8 * lane + e] = wv * NST[p * 64 + 8 * lane + e] + cs[e]; } }
        MX_BAR();
        if (FULL) {
            v2u gw[4];
#pragma unroll
            for (int tb = 0; tb < 4; ++tb) gw[tb] = *(const LAS v2u*)(I + L_G + off_b(16 * tb + l15, 2 * w + (g >> 1)) + 8 * (g & 1));
#pragma unroll
            for (int tb = 0; tb < 4; ++tb)
#pragma unroll
                for (int ks = 0; ks < 2; ++ks) if (ks <= (tb >> 1))
                    O[tb] = MX_MFMA(cat(vlo[ks], vhi[ks]), *(const LAS bf16x8*)(L + L_XT + (16 * tb + l15) * XT_STRIDE + (32 * ks + 8 * g) * 2), O[tb]);
            if (w == 1) { float sx = 0.f, qn = 0.f;
#pragma unroll
                for (int ch = 0; ch < 8; ++ch) { const v4u xv = *(const LAS v4u*)(L + L_XT + lane * XT_STRIDE + 16 * ch);
                    if (ch < 2 * ((lane >> 4) + 1)) sx += (bflo(xv.x) + bfhi(xv.x)) + (bflo(xv.y) + bfhi(xv.y)) + (bflo(xv.z) + bfhi(xv.z)) + (bflo(xv.w) + bfhi(xv.w));
                    const v4u qv = *(const LAS v4u*)(I + L_QT + off_b(lane, ch)); const LAS float* nn = NST + p * 64 + 8 * ch;
                    qn += bflo(qv.x) * nn[0] + bfhi(qv.x) * nn[1] + bflo(qv.y) * nn[2] + bfhi(qv.y) * nn[3] + bflo(qv.z) * nn[4] + bfhi(qv.z) * nn[5] + bflo(qv.w) * nn[6] + bfhi(qv.w) * nn[7]; }
                DEN[p * 64 + lane] = sx + wv * qn; }
#pragma unroll
            for (int tb = 0; tb < 4; ++tb) { float ss = (O[tb][0] * O[tb][0] + O[tb][1] * O[tb][1]) + (O[tb][2] * O[tb][2] + O[tb][3] * O[tb][3]);
                ss += __shfl_xor(ss, 16); ss += __shfl_xor(ss, 32);
                if (g == 0) *(LAS float*)(L + L_PART + (p * 512 + w * 64 + 16 * tb + l15) * 4) = ss; }
            MX_BAR();
            float scale[4];
#pragma unroll
            for (int tb = 0; tb < 4; ++tb) { const int t = 16 * tb + l15; float tot = 0.f;
#pragma unroll
                for (int ww = 0; ww < 8; ++ww) tot += *(const LAS float*)(L + L_PART + (p * 512 + ww * 64 + t) * 4);
                const float dd = fmaxf(fabsf(DEN[p * 64 + t]), GT[c * 128 + 64 + t]);
                scale[tb] = rsqrtf(tot * (1.0f / 128.0f) + RMS_EPS * dd * dd); }
            out_store(OB + (rowc + l15) * D + 512 + h * 128 + 16 * w + 4 * g, O, scale, gn, gw);
        }
    }
#undef ML_WRITE
#undef ML_LOAD
    if (!FULL) {
        const int lane = F.lane;
#pragma unroll
        for (int db = 0; db < 4; ++db) *(f32x4*)(SST + ((w * 4 + db) * 64 + lane) * 4) = S[db];
        if (tid < 64) MLN[tid] = NST[tid];
        if (tid == 0) { MLS[0] = GT[NCH * 132 + 1]; MLS[1] = GT[NCH * 132]; }
    }
    MX_BAR();
}

template <bool FULL>
__device__ __forceinline__ void mixer_pass(const Frame& F, const Args& a) {
    if (F.vcu & 1) {
        for (int u = F.vcu; u < NUNIT; u += F.G) ml_unit<FULL>(F, a, u);
        for (int u = F.vcu; u < NUNIT; u += F.G) hg_unit<FULL>(F, a, u);
    } else {
        for (int u = F.vcu; u < NUNIT; u += F.G) hg_unit<FULL>(F, a, u);
        for (int u = F.vcu; u < NUNIT; u += F.G) ml_unit<FULL>(F, a, u);
    }
}
__device__ __forceinline__ void scan_pass(const Frame& F, const Args& a) {
    unsigned char* ws = a.ws;
    const size_t gt = (size_t)F.vcu * (NWAVES * 64) + F.tid, GT = (size_t)F.G * (NWAVES * 64);
    const float* HGS = (const float*)(ws + WS_HGS); const float* MLSt = (const float*)(ws + WS_MLC);
    float* HGI = (float*)(ws + WS_HGI); float* MLCI = (float*)(ws + WS_MLCI); float* MLNI = (float*)(ws + WS_MLNI); float* MLI = (float*)(ws + WS_MLI);
    const float* ASC = (const float*)(ws + WS_ASC); const float* MLS = (const float*)(ws + WS_MLS); const float* MLN = (const float*)(ws + WS_MLN);
    constexpr size_t N_HG = 16 * 4096, N_MLC = 16 * 2048, N_MLN = 16 * 16;
    for (size_t e0 = gt; e0 < N_HG + N_MLC + N_MLN; e0 += GT) {
        if (e0 < N_HG) { const int bh = (int)(e0 >> 12), e4 = (int)(e0 & 4095); const int d = 16 * ((e4 >> 6) & 7) + 4 * ((e4 & 63) >> 4);
            f32x4 run = {0.f, 0.f, 0.f, 0.f};
            for (int s0 = 0; s0 < NSC; s0 += 16) { f32x4 loc[16], av[16];
#pragma unroll
                for (int k = 0; k < 16; ++k) { const size_t uid = (size_t)bh * NSC + s0 + k; loc[k] = *(const f32x4*)(HGS + uid * 16384 + 4 * e4); av[k] = *(const f32x4*)(ASC + uid * 128 + d); }
#pragma unroll
                for (int k = 0; k < 16; ++k) { const size_t uid = (size_t)bh * NSC + s0 + k; *(f32x4*)(HGI + uid * 16384 + 4 * e4) = run; run = av[k] * run + loc[k]; } }
        } else { const size_t e1 = e0 - N_HG; const bool isn = e1 >= N_MLC; const int bh = isn ? (int)((e1 - N_MLC) >> 4) : (int)(e1 >> 11), e4 = isn ? (int)((e1 - N_MLC) & 15) : (int)(e1 & 2047);
            f32x4 run = {0.f, 0.f, 0.f, 0.f}; float m = 0.f;
            for (int s0 = 0; s0 < NSC; s0 += 16) { f32x4 loc[16]; float Gv[16], mlv[16];
#pragma unroll
                for (int k = 0; k < 16; ++k) { const size_t uid = (size_t)bh * NSC + s0 + k; Gv[k] = MLS[uid * 4]; mlv[k] = MLS[uid * 4 + 1];
                    loc[k] = isn ? *(const f32x4*)(MLN + uid * 64 + 4 * e4) : *(const f32x4*)(MLSt + uid * 8192 + 4 * e4); }
#pragma unroll
                for (int k = 0; k < 16; ++k) { const size_t uid = (size_t)bh * NSC + s0 + k;
                    if (isn) *(f32x4*)(MLNI + uid * 64 + 4 * e4) = run; else *(f32x4*)(MLCI + uid * 8192 + 4 * e4) = run;
                    if (!isn && e4 == 0) MLI[uid] = m;
                    const float mn = fmaxf(m + Gv[k], mlv[k]); run = run * __expf(m + Gv[k] - mn) + loc[k] * __expf(mlv[k] - mn); m = mn; } }
        }
    }
}
}

__global__ void __launch_bounds__(NWAVES * 64, 2) hymba_fwd(Args args) {
    extern __shared__ __attribute__((aligned(16))) unsigned char lds[];
    Frame F;
    F.lds = (LAS unsigned char*)lds;
    F.tid = threadIdx.x; F.lane = F.tid & 63; F.wave = __builtin_amdgcn_readfirstlane(F.tid >> 6);
    F.G = gridDim.x; { const int bx = blockIdx.x; F.vcu = (F.G % 8 == 0) ? (bx % 8) * (F.G / 8) + bx / 8 : bx; }
    unsigned char* ws = args.ws;
    volatile LAS unsigned* MISC = (volatile LAS unsigned*)(F.lds + MISC_OFF);
    for (int u = F.tid; u < (LDS_BYTES - LDSCTL_OFF) / 4; u += NWAVES * 64) ((LAS unsigned*)(F.lds + LDSCTL_OFF))[u] = 0u;
    __syncthreads();
    XcdBarrier bar; bar.bar = (unsigned*)(ws + WS_CTL) + CW_BAR; bar.x = 0; bar.st = nullptr;
    if (N_LAUNCHES == 1) bar = xcd_barrier_post((unsigned*)(ws + WS_CTL) + CW_BAR, MISC + 8);
    const int lo = args.ph_lo, hi = args.ph_hi;
#ifndef PH_MASK
#define PH_MASK 0x1ff
#endif
#define IN(k) (((PH_MASK >> (k)) & 1) && lo <= (k) && (k) < hi)
#define BOTH(k) (IN(k) && IN((k) + 1))
#define GRID_BAR() do { if (N_LAUNCHES == 1) xcd_barrier(bar); } while (0)

    if (IN(0)) { p0_prologue(F, args); if (BOTH(0)) GRID_BAR(); }
    if (IN(1)) {
        pg8::Gemm g{(const bf16*)(ws + WS_XB), (const bf16*)(ws + WS_WIN), M, NIN, D}; pg8::StaticOrder S; S.init(M, NIN, F.G, (int)blockIdx.x);
        EpiInProj E{(bf16*)(ws + WS_U), (bf16*)(ws + WS_LOGF), (float*)(ws + WS_ER), (float*)(ws + WS_EL), args.in[3], (const float*)(ws + WS_OML)};
        pg8::gemm_phase<EpiInProj, pg8::StaticOrder, PG8_ALIGN, PG8_SP2>(F.lds + RING_OFF, g, S, E);
        if (BOTH(1)) GRID_BAR();
    }
    if (IN(2)) { mx::mixer_pass<false>(F, args); if (BOTH(2)) GRID_BAR(); }
    if (IN(3)) { mx::scan_pass(F, args);
        if (BOTH(3)) GRID_BAR(); }
    if (IN(4)) { mx::mixer_pass<true>(F, args);
        if (BOTH(4)) GRID_BAR(); }
    if (IN(5)) {
        pg8::Gemm g{(const bf16*)args.out, (const bf16*)(ws + WS_WOUT), M, D, D}; pg8::StaticOrder S; S.init(M, D, F.G, (int)blockIdx.x);
        EpiOutProj E{(const bf16*)(ws + WS_XB), (bf16*)(ws + WS_LOGF), (float*)(ws + WS_CTL + ((args.flags & 1) ? 768 * 1024 : CTL_ST1))};
        pg8::gemm_phase<EpiOutProj, pg8::StaticOrder, PG8_ALIGN, PG8_SP2>(F.lds + RING_OFF, g, S, E);
        if (BOTH(5)) GRID_BAR();
    }
    if (IN(6)) {
        pg8::Gemm g{(const bf16*)(ws + WS_LOGF), (const bf16*)(ws + WS_WGU), M, NGU, D}; pg8::StaticOrder S; S.init(M, NGU, F.G, (int)blockIdx.x);
        EpiGateUp E{(bf16*)(ws + WS_U), (const float*)(ws + WS_CTL + CTL_ST1), (const float*)(ws + WS_CTL + CTL_CS_GU), (const float*)(ws + WS_CTL + CTL_BW_GU)};
        pg8::gemm_phase<EpiGateUp, pg8::StaticOrder, PG8_ALIGN, PG8_SP2>(F.lds + RING_OFF, g, S, E);
        if (BOTH(6)) GRID_BAR();
    }
    if (IN(7)) {
        pg8::Gemm g{(const bf16*)(ws + WS_U), (const bf16*)(ws + WS_WDN), M, D, FF}; pg8::StaticOrder S; S.init(M, D, F.G, (int)blockIdx.x);
        EpiDown E{(bf16*)(ws + WS_LOGF), (const float*)(ws + WS_CTL + CTL_ST1), (float*)(ws + WS_CTL + CTL_ST2), args.in[10], args.in[11]};
        pg8::gemm_phase<EpiDown, pg8::StaticOrder, PG8_ALIGN, PG8_SP2>(F.lds + RING_OFF, g, S, E);
    }
    if (IN(8)) {
#ifndef NO_PGEMM
        {   int kp = PLE; asm volatile("" : "+s"(kp));
            pg8::Gemm g{(const bf16*)(ws + WS_PB), (const bf16*)(ws + WS_WPP), M, D, kp}; pg8::StaticOrder S; S.init(M, D, F.G, (int)blockIdx.x);
            EpiPleP E{(pg8::u32x4*)(ws + WS_XB)};
            pg8::gemm_phase<EpiPleP, pg8::StaticOrder, PG8_ALIGN, PG8_SP2>(F.lds + RING_OFF, g, S, E); }
#endif
        VM_WAIT(); __syncthreads();
        if (BOTH(7)) GRID_BAR();
#ifndef NO_FGEMM
        {   pg8::Gemm g{(const bf16*)(ws + WS_LOGF), (const bf16*)(ws + WS_WPG), M, D, D}; pg8::StaticOrder S; S.init(M, D, F.G, (int)blockIdx.x);
            EpiFinal E{args.out, (const bf16*)(ws + WS_LOGF), (const pg8::u32x4*)(ws + WS_XB), (const float*)(ws + WS_CTL + CTL_ST2), args.in[15], args.in[16], (const float*)(ws + WS_CTL + CTL_CS_PG), (const float*)(ws + WS_CTL + CTL_BW_PG), args.in[19]};
            pg8::gemm_phase<EpiFinal, pg8::StaticOrder, PG8_ALIGN, PG8_SP2>(F.lds + RING_OFF, g, S, E); }
#endif
    }
#undef IN
#undef BOTH
#undef GRID_BAR
}

extern "C" void kernel_launch(void* const* d_in, const int* in_sizes, int n_in, void* d_out, int out_size, void* d_ws, size_t ws_size, hipStream_t stream) {
    static int grid = 0;
    if (grid == 0) {
        if (n_in != 20 || in_sizes[0] != M * D || out_size != M * D || ws_size < WS_END) { fprintf(stderr, "kernel_launch: unexpected shapes: n_in %d in0 %d out %d ws %zu (need %zu)\n", n_in, n_in > 0 ? in_sizes[0] : -1, out_size, ws_size, (size_t)WS_END); grid = -1; return; }
        int dev = 0, cus = 0, per_cu = 0;
        if (hipGetDevice(&dev) != hipSuccess || hipDeviceGetAttribute(&cus, hipDeviceAttributeMultiprocessorCount, dev) != hipSuccess) { grid = -1; return; }
        if (hipFuncSetAttribute((const void*)hymba_fwd, hipFuncAttributeMaxDynamicSharedMemorySize, LDS_BYTES) != hipSuccess) { fprintf(stderr, "kernel_launch: hipFuncSetAttribute failed\n"); grid = -1; return; }
        if (hipOccupancyMaxActiveBlocksPerMultiprocessor(&per_cu, (const void*)hymba_fwd, NWAVES * 64, LDS_BYTES) != hipSuccess || per_cu < 1)
            fprintf(stderr, "kernel_launch: note: occupancy query reports %d workgroups per CU\n", per_cu);
        (void)hipGetLastError();
        grid = cus;
    }
    if (grid < 0) return;
    if (hipMemsetAsync((char*)d_ws + WS_CTL, 0, CTL_ZERO_BYTES, stream) != hipSuccess) { fprintf(stderr, "kernel_launch: memset failed\n"); return; }
    Args a{};
    for (int i = 0; i < 20; ++i) a.in[i] = (const float*)d_in[i];
    a.out = (float*)d_out; a.ws = (unsigned char*)d_ws;
    if (N_LAUNCHES == 1) { a.ph_lo = 0; a.ph_hi = NPHASE; hipLaunchKernelGGL(hymba_fwd, dim3(grid), dim3(NWAVES * 64), LDS_BYTES, stream, a); }
    else for (int li = 0; li < NPHASE; ++li) { a.ph_lo = li; a.ph_hi = li + 1;
#ifdef PROBE_PHASE
        if (li == PROBE_PHASE) { a.flags = 1; hipLaunchKernelGGL(hymba_fwd, dim3(grid), dim3(NWAVES * 64), LDS_BYTES, stream, a); a.flags = 0; }
#endif
        hipLaunchKernelGGL(hymba_fwd, dim3(grid), dim3(NWAVES * 64), LDS_BYTES, stream, a); }
}
```

```cpp
#include <hip/hip_runtime.h>
#include <cstdio>
#include <cstdint>


#ifndef MK_N_LAUNCHES
#define MK_N_LAUNCHES 1
#endif

namespace pg8 {
#define PG8_LAS __attribute__((address_space(3)))
typedef unsigned short bf16_t;
typedef short bf16x8 __attribute__((ext_vector_type(8)));
typedef float f32x4 __attribute__((ext_vector_type(4)));
typedef float f32x2 __attribute__((ext_vector_type(2)));
typedef unsigned u32x4 __attribute__((ext_vector_type(4)));
typedef unsigned u32x2 __attribute__((ext_vector_type(2)));
constexpr int BM = 256, BK = 64, HALF = 128, HTB = HALF * BK * 2, STAGE_BYTES = 8 * HTB, NXCD = 8, WGM = 8;

__host__ __device__ __forceinline__ int lds_byte(int r, int c) { const int st = (r >> 4) * 2 + (c >> 5), rr = r & 15, cc = c & 31, ob = rr * 64 + cc * 2; return st * 1024 + (ob ^ (((ob >> 9) & 1) << 5)); }
__host__ __device__ __forceinline__ void stage_rc(int b, int& R, int& C) { const int st = b / 1024, sb = b % 1024, swz = sb ^ (((sb >> 9) & 1) << 5); R = (st >> 1) * 16 + swz / 64; C = (st & 1) * 32 + (swz % 64) / 2; }
__host__ __device__ __forceinline__ int perm32(int rho) { const int n = rho >> 4, i = rho & 15; return 8 * (i >> 2) + 4 * n + (i & 3); }

struct Unit { int pm, pn; };
struct Gemm { const bf16_t* A; const bf16_t* Bt; int M, N, K; };

struct StaticOrder {
    int nM, nN, nwg, G, c;
    __host__ __device__ void init(int M, int N, int G_, int c_) { nM = M / BM; nN = N / BM; nwg = nM * nN; G = G_; c = c_; }
    __host__ __device__ bool next(int i, Unit& u) const {
        const long L = (long)i * G + c; if (L >= nwg) return false;
        int wgid = (int)L; { const int q = nwg / NXCD, r = nwg % NXCD, xcd = wgid % NXCD, off = wgid / NXCD; wgid = (xcd < r ? xcd * (q + 1) : r * (q + 1) + (xcd - r) * q) + off; }
        const int nig = WGM * nN, gid = wgid / nig, fm = gid * WGM, gsz = (nM - fm) < WGM ? (nM - fm) : WGM;
        u.pm = fm + ((wgid % nig) % gsz); u.pn = (wgid % nig) / gsz; return true;
    }
    __device__ __forceinline__ void a_ready(const Unit&) const {}
    __device__ __forceinline__ void done(const Unit&) const {}
};

typedef __bf16 bf16v2_t __attribute__((ext_vector_type(2)));
__device__ __forceinline__ unsigned cvt_pk_bf16(float lo, float hi) { const f32x2 v = {lo, hi}; return __builtin_bit_cast(unsigned, __builtin_convertvector(v, bf16v2_t)); }

template <class Epi, class Sched, bool ALIGN_EPI = false, bool SP2 = false>
__device__ __forceinline__ void gemm_phase(PG8_LAS unsigned char* lds, const Gemm g, const Sched& S, const Epi& E) {
    const int tid = threadIdx.x, wid = __builtin_amdgcn_readfirstlane(tid >> 6), lane = tid & 63, wr = wid >> 2, wc = wid & 3, fr = lane & 15, fq = lane >> 4;
    const int K = g.K, nt = K / BK;
    unsigned voffA[2], voffB[2];
#pragma unroll
    for (int i = 0; i < 2; ++i) { int R, C; stage_rc(tid * 16 + i * 8192, R, C); const int Rb = Epi::PERM ? ((R & ~31) + perm32(R & 31)) : R;
        voffA[i] = (unsigned)(R * K + C) * 2u; voffB[i] = (unsigned)(Rb * K + C) * 2u; }
    const size_t kstep = (size_t)(BK * 2);
    const size_t hstep = (size_t)HALF * K * 2;
    const size_t tstep = 2 * hstep;
    const unsigned ldsw = (unsigned)wid * 1024u;
    const int aoff = lds_byte(wr * 64 + fr, fq * 8), boff = lds_byte(wc * 32 + fr, fq * 8);
#define PG8_SA(b, h) (((b) * 2 + (h)) * HTB)
#define PG8_SB(b, h) ((4 + (b) * 2 + (h)) * HTB)
#define PG8_STAGE(bufoff, gbase, voff) do { _Pragma("unroll") for (int _i = 0; _i < 2; ++_i) \
        __builtin_amdgcn_global_load_lds((const unsigned*)((const char*)(gbase) + (voff)[_i]), (PG8_LAS unsigned*)(lds + (bufoff) + ldsw + _i * 8192), 16, 0, 0); } while (0)
#define PG8_LDA(dst, b, h) do { _Pragma("unroll") for (int m = 0; m < 4; ++m) _Pragma("unroll") for (int k = 0; k < 2; ++k) dst[m][k] = *(const PG8_LAS bf16x8*)(lds + PG8_SA(b, h) + aoff + m * 2048 + k * 1024); } while (0)
#define PG8_LDB(dst, b, h) do { _Pragma("unroll") for (int n = 0; n < 2; ++n) _Pragma("unroll") for (int k = 0; k < 2; ++k) dst[n][k] = *(const PG8_LAS bf16x8*)(lds + PG8_SB(b, h) + boff + n * 2048 + k * 1024); } while (0)
#define PG8_MMA(ai, bj, At, Bt) do { __builtin_amdgcn_s_setprio(1); _Pragma("unroll") for (int m = 0; m < 4; ++m) _Pragma("unroll") for (int n = 0; n < 2; ++n) _Pragma("unroll") for (int k = 0; k < 2; ++k) \
        acc[ai][bj][m][n] = __builtin_amdgcn_mfma_f32_16x16x32_bf16(Bt[n][k], At[m][k], acc[ai][bj][m][n], 0, 0, 0); __builtin_amdgcn_s_setprio(0); } while (0)
#define PG8_WAIT_V(n) asm volatile("s_waitcnt vmcnt(" #n ")" ::: "memory")
#define PG8_WAIT_L(n) asm volatile("s_waitcnt lgkmcnt(" #n ")" ::: "memory")
#define PG8_BAR __builtin_amdgcn_s_barrier()
#define PG8_SCHED __builtin_amdgcn_sched_barrier(0)
    Unit cur, nxt; int ui = 0;
    if (!S.next(0, cur)) return;
    f32x4 acc[2][2][4][2];
#pragma unroll
    for (int a = 0; a < 2; ++a)
#pragma unroll
        for (int b = 0; b < 2; ++b)
#pragma unroll
            for (int m = 0; m < 4; ++m)
#pragma unroll
                for (int n = 0; n < 2; ++n) acc[a][b][m][n] = (f32x4){0.f, 0.f, 0.f, 0.f};
    bf16x8 At[4][2], B0[2][2], B1[2][2];
    const char* cA = (const char*)g.A + (size_t)cur.pm * tstep; const char* cB = (const char*)g.Bt + (size_t)cur.pn * tstep;
    S.a_ready(cur);
    if constexpr (SP2) {
        PG8_STAGE(PG8_SB(0, 0), cB, voffB); PG8_STAGE(PG8_SB(0, 1), cB + hstep, voffB); PG8_STAGE(PG8_SA(0, 0), cA, voffA); PG8_STAGE(PG8_SA(0, 1), cA + hstep, voffA);
        if (wr == 1) PG8_BAR;
        PG8_WAIT_V(2); PG8_BAR;
        PG8_STAGE(PG8_SB(1, 0), cB + kstep, voffB); PG8_STAGE(PG8_SA(1, 0), cA + kstep, voffA); PG8_STAGE(PG8_SB(1, 1), cB + hstep + kstep, voffB);
        PG8_WAIT_V(6); PG8_BAR;
    } else {
        PG8_STAGE(PG8_SB(0, 0), cB, voffB); PG8_STAGE(PG8_SA(0, 0), cA, voffA); PG8_STAGE(PG8_SB(0, 1), cB + hstep, voffB); PG8_STAGE(PG8_SA(0, 1), cA + hstep, voffA);
        if (wr == 1) PG8_BAR;
        PG8_WAIT_V(4); PG8_BAR;
        PG8_STAGE(PG8_SB(1, 0), cB + kstep, voffB); PG8_STAGE(PG8_SA(1, 0), cA + kstep, voffA); PG8_STAGE(PG8_SB(1, 1), cB + hstep + kstep, voffB);
        PG8_WAIT_V(6); PG8_BAR;
    }
    for (;;) {
        const bool has_next = S.next(ui + 1, nxt);
        const char* nA = has_next ? (const char*)g.A + (size_t)nxt.pm * tstep : cA; const char* nB = has_next ? (const char*)g.Bt + (size_t)nxt.pn * tstep : cB;
        for (int t = 0; t < nt; t += 2) {
            const bool last = (t == nt - 2);
            const char* a1 = cA + (size_t)(t + 1) * kstep;
            const char* a2 = last ? nA : cA + (size_t)(t + 2) * kstep; const char* b2 = last ? nB : cB + (size_t)(t + 2) * kstep;
            const char* a3 = a2 + kstep; const char* b3 = b2 + kstep;
            if (last && has_next) S.a_ready(nxt);
            if constexpr (SP2) {
            PG8_LDB(B0, 0, 0); PG8_LDB(B1, 0, 1); PG8_SCHED; PG8_LDA(At, 0, 0); PG8_STAGE(PG8_SA(1, 1), a1 + hstep, voffA);
            PG8_WAIT_V(8); PG8_WAIT_L(0); PG8_BAR; PG8_MMA(0, 0, At, B0); PG8_MMA(0, 1, At, B1); PG8_BAR; PG8_SCHED;
            PG8_LDA(At, 0, 1); PG8_STAGE(PG8_SB(0, 0), b2, voffB); PG8_STAGE(PG8_SB(0, 1), b2 + hstep, voffB); PG8_STAGE(PG8_SA(0, 0), a2, voffA);
            PG8_WAIT_V(8); PG8_WAIT_L(0); PG8_BAR; PG8_MMA(1, 0, At, B0); PG8_MMA(1, 1, At, B1); PG8_BAR; PG8_SCHED;
            PG8_LDB(B0, 1, 0); PG8_LDB(B1, 1, 1); PG8_SCHED; PG8_LDA(At, 1, 0); PG8_STAGE(PG8_SA(0, 1), a2 + hstep, voffA);
            PG8_WAIT_V(8); PG8_WAIT_L(0); PG8_BAR; PG8_MMA(0, 0, At, B0); PG8_MMA(0, 1, At, B1); PG8_BAR; PG8_SCHED;
            PG8_LDA(At, 1, 1); PG8_STAGE(PG8_SB(1, 0), b3, voffB); PG8_STAGE(PG8_SB(1, 1), b3 + hstep, voffB); PG8_STAGE(PG8_SA(1, 0), a3, voffA);
            PG8_WAIT_V(8); PG8_WAIT_L(0); PG8_BAR; PG8_MMA(1, 0, At, B0); PG8_MMA(1, 1, At, B1); PG8_BAR; PG8_SCHED;
            } else {
            PG8_LDB(B0, 0, 0); PG8_SCHED; PG8_LDA(At, 0, 0); PG8_STAGE(PG8_SA(1, 1), a1 + hstep, voffA);
            PG8_WAIT_L(8); PG8_BAR; PG8_WAIT_L(0); PG8_MMA(0, 0, At, B0); PG8_BAR; PG8_SCHED;
            PG8_LDB(B1, 0, 1); PG8_STAGE(PG8_SB(0, 0), b2, voffB);
            PG8_BAR; PG8_WAIT_L(0); PG8_MMA(0, 1, At, B1); PG8_BAR;
            PG8_LDA(At, 0, 1); PG8_STAGE(PG8_SA(0, 0), a2, voffA);
            PG8_BAR; PG8_WAIT_L(0); PG8_MMA(1, 0, At, B0); PG8_BAR; PG8_SCHED;
            PG8_STAGE(PG8_SB(0, 1), b2 + hstep, voffB);
            PG8_WAIT_V(6); PG8_BAR; PG8_MMA(1, 1, At, B1); PG8_BAR;
            PG8_LDB(B0, 1, 0); PG8_SCHED; PG8_LDA(At, 1, 0); PG8_STAGE(PG8_SA(0, 1), a2 + hstep, voffA);
            PG8_WAIT_L(8); PG8_BAR; PG8_WAIT_L(0); PG8_MMA(0, 0, At, B0); PG8_BAR; PG8_SCHED;
            PG8_LDB(B1, 1, 1); PG8_STAGE(PG8_SB(1, 0), b3, voffB);
            PG8_BAR; PG8_WAIT_L(0); PG8_MMA(0, 1, At, B1); PG8_BAR;
            PG8_LDA(At, 1, 1); PG8_STAGE(PG8_SA(1, 0), a3, voffA);
            PG8_BAR; PG8_WAIT_L(0); PG8_MMA(1, 0, At, B0); PG8_BAR; PG8_SCHED;
            PG8_STAGE(PG8_SB(1, 1), b3 + hstep, voffB);
            PG8_WAIT_V(6); PG8_BAR; PG8_MMA(1, 1, At, B1); PG8_BAR;
            }
        }
        if constexpr (ALIGN_EPI) { if (wr == 0) PG8_BAR; }
        E(acc, cur, wr, wc, fr, fq); S.done(cur);
        if (!has_next) break;
#pragma unroll
        for (int a = 0; a < 2; ++a)
#pragma unroll
            for (int b = 0; b < 2; ++b)
#pragma unroll
                for (int m = 0; m < 4; ++m)
#pragma unroll
                    for (int n = 0; n < 2; ++n) acc[a][b][m][n] = (f32x4){0.f, 0.f, 0.f, 0.f};
        cur = nxt; cA = nA; cB = nB; ++ui;
        if constexpr (ALIGN_EPI) { if (wr == 1) PG8_BAR; }
    }
    PG8_WAIT_V(0);
    if constexpr (!ALIGN_EPI) { if (wr == 0) PG8_BAR; }
    PG8_BAR;
#undef PG8_SA
#undef PG8_SB
#undef PG8_STAGE
#undef PG8_LDA
#undef PG8_LDB
#undef PG8_MMA
#undef PG8_WAIT_V
#undef PG8_WAIT_L
#undef PG8_BAR
#undef PG8_SCHED
}
}

#ifndef PG8_SP2
#define PG8_SP2 true
#endif
#ifndef PG8_ALIGN
#define PG8_ALIGN true
#endif

constexpr int NWAVES = 8;
constexpr int NPHASE = 9;
constexpr int N_LAUNCHES = MK_N_LAUNCHES;
constexpr int BATCH = 4, SEQ = 8192, D = 1024, M = BATCH * SEQ, PLE = 256, FF = 2816;
constexpr int PROJW = 3592, NIN = 3584;
constexpr int NGU = 2 * FF;
constexpr size_t MiB0 = 1u << 20;
constexpr float ALPHA = 1.189207115002721f;
constexpr float LN_EPS = 1e-5f, RMS_EPS = 1e-6f;
constexpr size_t UO_Q = 0, UO_K = 32 * MiB0, UO_V = 64 * MiB0, UO_G = 96 * MiB0, UO_MQ = 128 * MiB0, UO_MK = 144 * MiB0, UO_MV = 160 * MiB0, UO_MO = 192 * MiB0;
constexpr int C_HQ = 0, C_HF = 512, C_HV = 1024, C_HG = 1536, C_MQ = 2048, C_MK = 2304, C_MV = 2560, C_MO = 3072;

constexpr size_t MiB = 1u << 20;
constexpr size_t WS_CTL = 0, CTL_ZERO_BYTES = 1 * MiB;
constexpr int CW_BAR = 4096;
constexpr size_t CTL_CS_GU = 64 * 1024, CTL_BW_GU = CTL_CS_GU + NGU * 4, CTL_CS_PG = CTL_BW_GU + NGU * 4, CTL_BW_PG = CTL_CS_PG + D * 4;
static_assert(CTL_BW_PG + D * 4 <= 128 * 1024, "ctl vectors");
constexpr size_t CTL_ST1 = 256 * 1024, CTL_ST2 = 512 * 1024;
static_assert(CTL_ST2 + (size_t)M * 8 <= CTL_ZERO_BYTES, "ctl stats");
constexpr size_t WS_OML = 1 * MiB;
constexpr size_t WS_WIN = 2 * MiB;
constexpr size_t WS_WOUT = 9 * MiB;
constexpr size_t WS_WGU = 11 * MiB;
constexpr size_t WS_WDN = 22 * MiB;
constexpr size_t WS_WPG = 28 * MiB;
constexpr size_t WS_WPP = 30 * MiB;
constexpr size_t WS_GATES = 31 * MiB;
constexpr size_t WS_XB = 32 * MiB;
constexpr size_t WS_PB = 96 * MiB;
constexpr size_t WS_U = 112 * MiB;
constexpr size_t WS_LOGF = 336 * MiB;
constexpr size_t WS_ER = 400 * MiB;
constexpr size_t WS_EL = 401 * MiB;
constexpr size_t WS_ASC = 402 * MiB;
constexpr size_t WS_MLS = 403 * MiB;
constexpr size_t WS_MLN = 404 * MiB;
constexpr size_t WS_HGS = 408 * MiB;
constexpr size_t WS_MLC = 440 * MiB;
constexpr size_t WS_HGI = 456 * MiB;
constexpr size_t WS_MLCI = 488 * MiB;
constexpr size_t WS_MLNI = 504 * MiB;
constexpr size_t WS_MLI = 505 * MiB;
constexpr size_t WS_END = 506 * MiB;

constexpr int RING_OFF = 0, RING_BYTES = 131072;
constexpr int LDS_BYTES = 163840;
constexpr int LDSCTL_OFF = LDS_BYTES - 1024, MISC_OFF = LDSCTL_OFF + 320;

#define GAS __attribute__((address_space(1)))
#define LAS __attribute__((address_space(3)))
typedef unsigned short bf16;
typedef unsigned v4u __attribute__((ext_vector_type(4)));
typedef unsigned v2u __attribute__((ext_vector_type(2)));
typedef float f32x4 __attribute__((ext_vector_type(4)));
typedef float f32x2 __attribute__((ext_vector_type(2)));
typedef GAS unsigned gu32;
#define RLX_AGENT __ATOMIC_RELAXED, __HIP_MEMORY_SCOPE_AGENT
#define LDS_WAIT() asm volatile("s_waitcnt lgkmcnt(0)" ::: "memory")
#define VM_WAIT() asm volatile("s_waitcnt vmcnt(0)" ::: "memory")
__device__ __forceinline__ unsigned f2bf(float f) { unsigned u = __builtin_bit_cast(unsigned, f); return (u + 0x7fffu + ((u >> 16) & 1u)) >> 16; }
__device__ __forceinline__ unsigned pk2(float lo, float hi) { return f2bf(lo) | (f2bf(hi) << 16); }
__device__ __forceinline__ float bf2f(unsigned short b) { return __builtin_bit_cast(float, (unsigned)b << 16); }
__device__ __forceinline__ float bflo(unsigned w) { return __builtin_bit_cast(float, w << 16); }
__device__ __forceinline__ float bfhi(unsigned w) { return __builtin_bit_cast(float, w & 0xffff0000u); }
__device__ __forceinline__ float fsigmoid(float x) { return __builtin_amdgcn_rcpf(1.0f + __expf(-x)); }
__device__ __forceinline__ float fsilu(float x) { return x * fsigmoid(x); }
__device__ __forceinline__ float wave_sum(float v) {
#pragma unroll
    for (int o = 1; o < 64; o <<= 1) v += __shfl_xor(v, o);
    return v;
}

#define XB_TMO      128
#define XB_XCNT(j)  (256  + 64 * (j))
#define XB_XSUB(j)  (1280 + 64 * (j))
#define XB_XGEN(j)  (2304 + 64 * (j))
#define XB_TOP      3328
#define XB_TOPGEN   3392
#define XCD_BAR_WORDS 3456
#define XB_SPIN_CAP (1u << 22)
__device__ __forceinline__ unsigned xb_ld(unsigned* p)              { return __hip_atomic_load(p, __ATOMIC_RELAXED, __HIP_MEMORY_SCOPE_AGENT); }
__device__ __forceinline__ unsigned xb_add(unsigned* p, unsigned v) { return __hip_atomic_fetch_add(p, v, __ATOMIC_RELAXED, __HIP_MEMORY_SCOPE_AGENT); }
__device__ __forceinline__ unsigned xb_xcc_id() { return (unsigned)__builtin_amdgcn_s_getreg((3 << 11) | 20) & 0xFu; }
#define XB_SPIN(cond, bar) do { unsigned _sp = 0; while (cond) { __builtin_amdgcn_s_sleep(1); \
    if ((++_sp & 255u) == 0u) { if (xb_ld(&(bar)[XB_TMO])) break; if (_sp > XB_SPIN_CAP) { atomicAdd(&(bar)[XB_TMO], 1u); break; } } } } while (0)
struct XcdBarrier { unsigned* bar; unsigned x; volatile LAS unsigned* st; };
__device__ __forceinline__ XcdBarrier xcd_barrier_post(unsigned* bar, volatile LAS unsigned* st) {
    XcdBarrier b; b.bar = bar; b.x = xb_xcc_id(); b.st = st;
    if (threadIdx.x == 0) (void)xb_add(&bar[XB_XCNT(b.x)], 1u);
    return b;
}
__device__ __forceinline__ void xcd_barrier_complete(unsigned* bar, unsigned x, unsigned& nloc, unsigned& nx) {
    const unsigned G = gridDim.x * gridDim.y * gridDim.z;
    unsigned sum, cnt, mine, sp = 0u;
    for (;;) {
        sum = 0u; cnt = 0u; mine = 0u;
#pragma unroll
        for (unsigned j = 0; j < 16; ++j) { const unsigned c = xb_ld(&bar[XB_XCNT(j)]); sum += c; cnt += (c > 0u) ? 1u : 0u; mine = (j == x) ? c : mine; }
        if (sum == G) break;
        __builtin_amdgcn_s_sleep(1);
        if ((++sp & 255u) == 0u) { if (xb_ld(&bar[XB_TMO])) break; if (sp > XB_SPIN_CAP) { atomicAdd(&bar[XB_TMO], 1u); break; } }
    }
    nloc = mine > 0u ? mine : 1u; nx = cnt > 0u ? cnt : 1u;
}
__device__ __forceinline__ void xcd_barrier(const XcdBarrier& b) {
    asm volatile("s_waitcnt vmcnt(0)" ::: "memory");
    __syncthreads();
    if (threadIdx.x == 0) {
        unsigned* bar = b.bar;
        __builtin_amdgcn_s_waitcnt(0);
        unsigned nloc = b.st[0], nx = b.st[1];
        if (nloc == 0u) { xcd_barrier_complete(bar, b.x, nloc, nx); b.st[0] = nloc; b.st[1] = nx; }
        const unsigned old = xb_add(&bar[XB_XSUB(b.x)], 1u);
        const unsigned gen = old / nloc;
        if (old + 1u == (gen + 1u) * nloc) {
            __builtin_amdgcn_fence(__ATOMIC_RELEASE, "agent");
            asm volatile("s_waitcnt vmcnt(0)" ::: "memory");
            const unsigned og = xb_add(&bar[XB_TOP], 1u);
            const unsigned tg = og / nx;
            if (og + 1u == (tg + 1u) * nx) xb_add(&bar[XB_TOPGEN], 1u);
            else XB_SPIN(xb_ld(&bar[XB_TOPGEN]) == tg, bar);
            __builtin_amdgcn_fence(__ATOMIC_ACQUIRE, "agent");
            xb_add(&bar[XB_XGEN(b.x)], 1u);
            asm volatile("s_waitcnt vmcnt(0)" ::: "memory");
        } else {
            XB_SPIN(xb_ld(&bar[XB_XGEN(b.x)]) == gen, bar);
            __builtin_amdgcn_fence(__ATOMIC_ACQUIRE, "agent");
            asm volatile("s_waitcnt vmcnt(0)" ::: "memory");
        }
    }
    __syncthreads();
}

using pg8::Unit; using pg8::cvt_pk_bf16; using pg8::HALF; using pg8::BM;
#define HF_DPP(x, ctrl) __builtin_bit_cast(float, __builtin_amdgcn_update_dpp(0, __builtin_bit_cast(int, (x)), (ctrl), 0xF, 0xF, true))
struct EpiInProj {
    static constexpr bool PERM = true;
    bf16* U; bf16* EQ; float* ER; float* EL; const float* bias; const float* oml;
    __device__ __forceinline__ void operator()(const f32x4 (&acc)[2][2][4][2], const Unit& u, int wr, int wc, int fr, int fq) const {
        const int row0 = u.pm * BM + wr * 64 + fr, col0 = u.pn * BM + wc * 32 + 8 * fq;
        const int pn = u.pn;
        const int type = (pn < 4) ? 3 : (pn < 6) ? 0 : (pn < 8) ? 1 : (pn < 12) ? 0 : 2;
        if (type != 3) {
            f32x4 bv[2][2];
#pragma unroll
            for (int bj = 0; bj < 2; ++bj)
#pragma unroll
                for (int n = 0; n < 2; ++n) bv[bj][n] = *(const f32x4*)(bias + col0 + bj * HALF + 4 * n);
            const size_t tbase = (pn < 6) ? UO_V : (pn < 8) ? UO_G : (pn == 8) ? UO_MQ : (pn == 9) ? UO_MK : (pn < 12) ? UO_MV : UO_MO;
            const bool narrow = (pn == 8) || (pn == 9);
            const int hpair = narrow ? 0 : 2 * (pn & 1);
            bf16* dst[2];
#pragma unroll
            for (int bj = 0; bj < 2; ++bj) { const int head = narrow ? (2 * bj + (wc >> 1)) : (hpair + bj); const int colh = narrow ? ((wc & 1) * 32 + 8 * fq) : (wc * 32 + 8 * fq);
                dst[bj] = (bf16*)((char*)U + tbase) + (size_t)head * M * (narrow ? 64 : 128) + colh; }
            const int W = narrow ? 64 : 128;
#pragma unroll
            for (int ai = 0; ai < 2; ++ai)
#pragma unroll
                for (int m = 0; m < 4; ++m) { const size_t row = (size_t)(row0 + ai * HALF + m * 16);
#pragma unroll
                    for (int bj = 0; bj < 2; ++bj) { f32x4 v0 = acc[ai][bj][m][0] + bv[bj][0], v1 = acc[ai][bj][m][1] + bv[bj][1];
                        if (type == 1) {
#pragma unroll
                            for (int j = 0; j < 4; ++j) { v0[j] = fsilu(v0[j]); v1[j] = fsilu(v1[j]); }
                        } else if (type == 2) {
#pragma unroll
                            for (int j = 0; j < 4; ++j) { v0[j] = fsigmoid(v0[j]); v1[j] = fsigmoid(v1[j]); }
                        }
                        pg8::u32x4 w; w.x = cvt_pk_bf16(v0[0], v0[1]); w.y = cvt_pk_bf16(v0[2], v0[3]); w.z = cvt_pk_bf16(v1[0], v1[1]); w.w = cvt_pk_bf16(v1[2], v1[3]);
                        *(pg8::u32x4*)(dst[bj] + row * W) = w; } }
        } else {
            const int ch = wc * 32 + 8 * fq;
#pragma unroll
            for (int ai = 0; ai < 2; ++ai) { const int cidx = u.pm * 4 + ai * 2 + wr;
#pragma unroll
                for (int n = 0; n < 2; ++n) { const size_t hoff = ((size_t)pn * M + (size_t)(row0 + ai * HALF)) * 128 + ch + 4 * n;
                    hf_block(acc[ai][1][0][n], acc[ai][1][1][n], acc[ai][1][2][n], acc[ai][1][3][n], acc[ai][0][0][n], acc[ai][0][1][n], acc[ai][0][2][n], acc[ai][0][3][n],
                             pn * 128 + ch + 4 * n, (bf16*)((char*)U + UO_Q) + hoff, (bf16*)((char*)U + UO_K) + hoff, cidx, fr); } }
        }
    }
    static __device__ __forceinline__ float hf_total(float scanv) {
        float o = scanv - HF_DPP(scanv, 0x111);
        o += HF_DPP(o, 0x128); o += HF_DPP(o, 0x124); o += HF_DPP(o, 0x122); o += HF_DPP(o, 0x121); return o; }
    __device__ __forceinline__ void hf_block(const f32x4& a0, const f32x4& a1, const f32x4& a2, const f32x4& a3, const f32x4& q0, const f32x4& q1, const f32x4& q2, const f32x4& q3, int c, bf16* uqp, bf16* ukp, int cidx, int fr) const {
        const f32x4 bv = *(const f32x4*)(bias + C_HF + c), ov = *(const f32x4*)(oml + c), bq = *(const f32x4*)(bias + C_HQ + c);
        f32x4 k0, k1, k2, k3, l0, l1, l2, l3;
#define HF_SCAN { x += HF_DPP(x, 0x111); x += HF_DPP(x, 0x112); x += HF_DPP(x, 0x114); x += HF_DPP(x, 0x118); }
#define HF_BC(v) hf_total(v)
#define HF_ONE(A, KK, LL) _Pragma("unroll") for (int j = 0; j < 4; ++j) { const float k = ov[j] * fsigmoid(-(A[j] + bv[j])); KK[j] = k; float x = __logf(1.0f - k); \
            HF_SCAN LL[j] = x; }
        HF_ONE(a0, k0, l0) __builtin_amdgcn_sched_barrier(0); HF_ONE(a1, k1, l1) __builtin_amdgcn_sched_barrier(0); HF_ONE(a2, k2, l2) __builtin_amdgcn_sched_barrier(0); HF_ONE(a3, k3, l3) __builtin_amdgcn_sched_barrier(0);
#undef HF_ONE
        f32x4 t0, t1, t2, t3;
#pragma unroll
        for (int j = 0; j < 4; ++j) { t0[j] = HF_BC(l0[j]); t1[j] = HF_BC(l1[j]); t2[j] = HF_BC(l2[j]); t3[j] = HF_BC(l3[j]); }
        const f32x4 r = t0 + t1, bl = r + t2 + t3;
        const f32x4 b0 = l0, b1 = l1 + t0, b2 = l2 + r, b3 = l3 + r + t2;
#define HF_ST(B, KK, QQ, M) { f32x4 e, kt; _Pragma("unroll") for (int j = 0; j < 4; ++j) { e[j] = fsilu(QQ[j] + bq[j]) * __expf(B[j] - r[j]); kt[j] = KK[j] * __expf(r[j] - B[j]); } \
            pg8::u32x2 we, wk; we.x = cvt_pk_bf16(e[0], e[1]); we.y = cvt_pk_bf16(e[2], e[3]); wk.x = cvt_pk_bf16(kt[0], kt[1]); wk.y = cvt_pk_bf16(kt[2], kt[3]); \
            *(pg8::u32x2*)(uqp + (size_t)(M) * 16 * 128) = we; *(pg8::u32x2*)(ukp + (size_t)(M) * 16 * 128) = wk; }
        HF_ST(b0, k0, q0, 0) __builtin_amdgcn_sched_barrier(0); HF_ST(b1, k1, q1, 1) __builtin_amdgcn_sched_barrier(0); HF_ST(b2, k2, q2, 2) __builtin_amdgcn_sched_barrier(0); HF_ST(b3, k3, q3, 3) __builtin_amdgcn_sched_barrier(0);
#undef HF_ST
        if (fr == 0) { f32x4 er, el;
#pragma unroll
            for (int j = 0; j < 4; ++j) { er[j] = __expf(r[j]); el[j] = __expf(bl[j] - r[j]); }
            *(f32x4*)(ER + (size_t)cidx * 512 + c) = er; *(f32x4*)(EL + (size_t)cidx * 512 + c) = el; }
    }
};
struct EpiOutProj {
    static constexpr bool PERM = true;
    const bf16* X; bf16* YB; float* ST;
    __device__ __forceinline__ void operator()(const f32x4 (&acc)[2][2][4][2], const Unit& u, int wr, int wc, int fr, int fq) const {
        const int row0 = u.pm * BM + wr * 64 + fr, col0 = u.pn * BM + wc * 32 + 8 * fq;
#pragma unroll
        for (int ai = 0; ai < 2; ++ai) {
            pg8::u32x4 xw[4][2];
#pragma unroll
            for (int m = 0; m < 4; ++m)
#pragma unroll
                for (int bj = 0; bj < 2; ++bj) xw[m][bj] = __builtin_nontemporal_load((const pg8::u32x4*)(X + (size_t)(row0 + ai * HALF + m * 16) * D + col0 + bj * HALF));
#pragma unroll
            for (int m = 0; m < 4; ++m) { const size_t row = (size_t)(row0 + ai * HALF + m * 16); const size_t off = row * D + col0; float s = 0.f, q = 0.f;
#pragma unroll
                for (int bj = 0; bj < 2; ++bj) { const pg8::u32x4 x = xw[m][bj];
                    const f32x4 x0 = {bflo(x.x), bfhi(x.x), bflo(x.y), bfhi(x.y)}, x1 = {bflo(x.z), bfhi(x.z), bflo(x.w), bfhi(x.w)};
                    const f32x4 v0 = x0 * ALPHA + acc[ai][bj][m][0], v1 = x1 * ALPHA + acc[ai][bj][m][1];
                    pg8::u32x4 w; w.x = cvt_pk_bf16(v0[0], v0[1]); w.y = cvt_pk_bf16(v0[2], v0[3]); w.z = cvt_pk_bf16(v1[0], v1[1]); w.w = cvt_pk_bf16(v1[2], v1[3]);
                    *(pg8::u32x4*)(YB + off + bj * HALF) = w;
                    s += (v0[0] + v0[1]) + (v0[2] + v0[3]) + (v1[0] + v1[1]) + (v1[2] + v1[3]);
                    q += (v0[0] * v0[0] + v0[1] * v0[1]) + (v0[2] * v0[2] + v0[3] * v0[3]) + (v1[0] * v1[0] + v1[1] * v1[1]) + (v1[2] * v1[2] + v1[3] * v1[3]); }
                s += __shfl_xor(s, 16); s += __shfl_xor(s, 32); q += __shfl_xor(q, 16); q += __shfl_xor(q, 32);
                if (fq == 0) { atomicAdd(ST + 2 * row, s); atomicAdd(ST + 2 * row + 1, q); } }
            asm volatile("" ::: "memory"); }
    }
};
struct EpiGateUp {
    static constexpr bool PERM = true;
    bf16* H; const float* ST; const float* cs; const float* bw;
    __device__ __forceinline__ void operator()(const f32x4 (&acc)[2][2][4][2], const Unit& u, int wr, int wc, int fr, int fq) const {
        const int row0 = u.pm * BM + wr * 64 + fr, cw = wc * 32 + 8 * fq;
        const int bcol = u.pn * BM + cw;
        f32x4 cg[2], cu[2], bg[2], bu[2];
#pragma unroll
        for (int n = 0; n < 2; ++n) { cg[n] = *(const f32x4*)(cs + bcol + 4 * n); cu[n] = *(const f32x4*)(cs + bcol + HALF + 4 * n); bg[n] = *(const f32x4*)(bw + bcol + 4 * n); bu[n] = *(const f32x4*)(bw + bcol + HALF + 4 * n); }
#pragma unroll
        for (int ai = 0; ai < 2; ++ai)
#pragma unroll
            for (int m = 0; m < 4; ++m) { const size_t row = (size_t)(row0 + ai * HALF + m * 16);
                const f32x2 st = *(const f32x2*)(ST + 2 * row); const float mu = st.x * (1.0f / D), var = st.y * (1.0f / D) - mu * mu, r = rsqrtf(fmaxf(var, 0.f) + LN_EPS);
                f32x4 hv[2];
#pragma unroll
                for (int n = 0; n < 2; ++n) {
#pragma unroll
                    for (int j = 0; j < 4; ++j) { const float g = r * (acc[ai][0][m][n][j] - mu * cg[n][j]) + bg[n][j]; const float up = r * (acc[ai][1][m][n][j] - mu * cu[n][j]) + bu[n][j]; hv[n][j] = fsilu(g) * up; } }
                pg8::u32x4 w; w.x = cvt_pk_bf16(hv[0][0], hv[0][1]); w.y = cvt_pk_bf16(hv[0][2], hv[0][3]); w.z = cvt_pk_bf16(hv[1][0], hv[1][1]); w.w = cvt_pk_bf16(hv[1][2], hv[1][3]);
                *(pg8::u32x4*)(H + row * FF + u.pn * HALF + cw) = w; }
    }
};
struct EpiDown {
    static constexpr bool PERM = true;
    bf16* YB; const float* ST1; float* ST2; const float* g1; const float* b1;
    __device__ __forceinline__ void operator()(const f32x4 (&acc)[2][2][4][2], const Unit& u, int wr, int wc, int fr, int fq) const {
        const int row0 = u.pm * BM + wr * 64 + fr, col0 = u.pn * BM + wc * 32 + 8 * fq;
        f32x4 gv[2][2], bv[2][2];
#pragma unroll
        for (int bj = 0; bj < 2; ++bj)
#pragma unroll
            for (int n = 0; n < 2; ++n) { gv[bj][n] = *(const f32x4*)(g1 + col0 + bj * HALF + 4 * n); bv[bj][n] = *(const f32x4*)(b1 + col0 + bj * HALF + 4 * n); }
#pragma unroll
        for (int ai = 0; ai < 2; ++ai) {
            pg8::u32x4 yw[4][2]; f32x2 st[4];
#pragma unroll
            for (int m = 0; m < 4; ++m) { const size_t row = (size_t)(row0 + ai * HALF + m * 16); st[m] = *(const f32x2*)(ST1 + 2 * row);
#pragma unroll
                for (int bj = 0; bj < 2; ++bj) yw[m][bj] = *(const pg8::u32x4*)(YB + row * D + col0 + bj * HALF); }
#pragma unroll
            for (int m = 0; m < 4; ++m) { const size_t row = (size_t)(row0 + ai * HALF + m * 16); const size_t off = row * D + col0; float s = 0.f, q = 0.f;
                const float mu = st[m].x * (1.0f / D), var = st[m].y * (1.0f / D) - mu * mu, r = rsqrtf(fmaxf(var, 0.f) + LN_EPS);
#pragma unroll
                for (int bj = 0; bj < 2; ++bj) { const pg8::u32x4 y = yw[m][bj];
                    const f32x4 y0 = {bflo(y.x), bfhi(y.x), bflo(y.y), bfhi(y.y)}, y1 = {bflo(y.z), bfhi(y.z), bflo(y.w), bfhi(y.w)};
                    const f32x4 x0 = (y0 - mu) * r * gv[bj][0] + bv[bj][0], x1 = (y1 - mu) * r * gv[bj][1] + bv[bj][1];
                    const f32x4 v0 = x0 * ALPHA + acc[ai][bj][m][0], v1 = x1 * ALPHA + acc[ai][bj][m][1];
                    pg8::u32x4 w; w.x = cvt_pk_bf16(v0[0], v0[1]); w.y = cvt_pk_bf16(v0[2], v0[3]); w.z = cvt_pk_bf16(v1[0], v1[1]); w.w = cvt_pk_bf16(v1[2], v1[3]);
                    *(pg8::u32x4*)(YB + off + bj * HALF) = w;
                    s += (v0[0] + v0[1]) + (v0[2] + v0[3]) + (v1[0] + v1[1]) + (v1[2] + v1[3]);
                    q += (v0[0] * v0[0] + v0[1] * v0[1]) + (v0[2] * v0[2] + v0[3] * v0[3]) + (v1[0] * v1[0] + v1[1] * v1[1]) + (v1[2] * v1[2] + v1[3] * v1[3]); }
                s += __shfl_xor(s, 16); s += __shfl_xor(s, 32); q += __shfl_xor(q, 16); q += __shfl_xor(q, 32);
                if (fq == 0) { atomicAdd(ST2 + 2 * row, s); atomicAdd(ST2 + 2 * row + 1, q); } }
            asm volatile("" ::: "memory"); }
    }
};
struct EpiPleP {
    static constexpr bool PERM = true;
    pg8::u32x4* SCR;
    __device__ __forceinline__ void operator()(const f32x4 (&acc)[2][2][4][2], const Unit& u, int wr, int wc, int fr, int fq) const {
        pg8::u32x4* slab = SCR + (size_t)(u.pm * 4 + u.pn) * 8192 + threadIdx.x;
#pragma unroll
        for (int ai = 0; ai < 2; ++ai)
#pragma unroll
            for (int m = 0; m < 4; ++m)
#pragma unroll
                for (int bj = 0; bj < 2; ++bj) { const f32x4 v0 = acc[ai][bj][m][0], v1 = acc[ai][bj][m][1];
                    pg8::u32x4 w; w.x = cvt_pk_bf16(v0[0], v0[1]); w.y = cvt_pk_bf16(v0[2], v0[3]); w.z = cvt_pk_bf16(v1[0], v1[1]); w.w = cvt_pk_bf16(v1[2], v1[3]);
                    slab[((ai * 4 + m) * 2 + bj) * 512] = w; }
    }
};
struct EpiFinal {
    static constexpr bool PERM = true;
    float* OUT; const bf16* YB; const pg8::u32x4* SCR; const float* ST2; const float* g2; const float* b2; const float* cs; const float* bw; const float* bgate;
    __device__ __forceinline__ void operator()(const f32x4 (&acc)[2][2][4][2], const Unit& u, int wr, int wc, int fr, int fq) const {
        const int row0 = u.pm * BM + wr * 64 + fr, col0 = u.pn * BM + wc * 32 + 8 * fq;
        const pg8::u32x4* slab = SCR + (size_t)(u.pm * 4 + u.pn) * 8192 + threadIdx.x;
        float mu[2][4], rr[2][4];
#pragma unroll
        for (int ai = 0; ai < 2; ++ai)
#pragma unroll
            for (int m = 0; m < 4; ++m) { const size_t row = (size_t)(row0 + ai * HALF + m * 16);
                const f32x2 st = *(const f32x2*)(ST2 + 2 * row); const float mean = st.x * (1.0f / D), var = st.y * (1.0f / D) - mean * mean; mu[ai][m] = mean; rr[ai][m] = rsqrtf(fmaxf(var, 0.f) + LN_EPS); }
#pragma unroll
        for (int bj = 0; bj < 2; ++bj) { const int c = col0 + bj * HALF;
            f32x4 gv[2], bv[2], cv[2], wv[2];
#pragma unroll
            for (int n = 0; n < 2; ++n) { gv[n] = *(const f32x4*)(g2 + c + 4 * n); bv[n] = *(const f32x4*)(b2 + c + 4 * n); cv[n] = *(const f32x4*)(cs + c + 4 * n); wv[n] = *(const f32x4*)(bw + c + 4 * n) + *(const f32x4*)(bgate + c + 4 * n); }
#pragma unroll
            for (int ai = 0; ai < 2; ++ai) {
#pragma unroll
                for (int m = 0; m < 4; ++m) { const size_t off = (size_t)(row0 + ai * HALF + m * 16) * D + c;
                    const pg8::u32x4 yw = *(const pg8::u32x4*)(YB + off), pw = __builtin_nontemporal_load(slab + ((ai * 4 + m) * 2 + bj) * 512);
                    const f32x4 y[2] = {{bflo(yw.x), bfhi(yw.x), bflo(yw.y), bfhi(yw.y)}, {bflo(yw.z), bfhi(yw.z), bflo(yw.w), bfhi(yw.w)}};
                    const f32x4 pp[2] = {{bflo(pw.x), bfhi(pw.x), bflo(pw.y), bfhi(pw.y)}, {bflo(pw.z), bfhi(pw.z), bflo(pw.w), bfhi(pw.w)}};
                    const float mean = mu[ai][m], r = rr[ai][m];
#pragma unroll
                    for (int n = 0; n < 2; ++n) { const f32x4 x2 = (y[n] - mean) * r * gv[n] + bv[n]; f32x4 o;
#pragma unroll
                        for (int j = 0; j < 4; ++j) { const float gp = r * (acc[ai][bj][m][n][j] - mean * cv[n][j]) + wv[n][j]; o[j] = x2[j] + fsigmoid(gp) * pp[n][j]; }
                        __builtin_nontemporal_store(o, (f32x4*)(OUT + off + 4 * n)); } }
                asm volatile("" ::: "memory"); } }
    }
};

struct Frame {
    LAS unsigned char* lds;
    int tid, lane, wave, vcu, G;
};

template <int MAP>
__device__ __forceinline__ void p0_transpose_item(const float* W, int K, int ldw, int nblk, bf16* WT, const float* gk, const float* bk, float* cs, float* bw, LAS float* scr, int item, int lane) {
    const int kb = item / nblk, nb = item % nblk, k0 = 64 * kb, n0 = 32 * nb;
#pragma unroll 8
    for (int i = 0; i < 32; ++i) { const int kk = 2 * i + (lane >> 5); scr[kk * 33 + (lane & 31)] = __builtin_nontemporal_load(W + (size_t)(k0 + kk) * ldw + n0 + (lane & 31)); }
    LDS_WAIT(); asm volatile("" ::: "memory");
    const int c = lane & 7;
    float gs[8], bs[8];
#pragma unroll
    for (int e = 0; e < 8; ++e) { gs[e] = gk ? gk[k0 + 8 * c + e] : 1.0f; bs[e] = bk ? bk[k0 + 8 * c + e] : 0.0f; }
#pragma unroll
    for (int j = 0; j < 4; ++j) { const int n = (lane >> 3) + 8 * j; const LAS float* s = scr + (8 * c) * 33 + n;
        float w[8]; float sb = 0.f;
#pragma unroll
        for (int e = 0; e < 8; ++e) { const float raw = s[e * 33]; sb += bs[e] * raw; w[e] = raw * gs[e]; }
        v4u o; o.x = pk2(w[0], w[1]); o.y = pk2(w[2], w[3]); o.z = pk2(w[4], w[5]); o.w = pk2(w[6], w[7]);
        const int ng = n0 + n;
        const int row = (MAP == 0) ? ng : (MAP == 3) ? ((ng < 512) ? ((ng >> 7) * 256 + (ng & 127)) : (ng < 1024) ? (((ng - 512) >> 7) * 256 + 128 + (ng & 127)) : ng)
                                     : ((ng >> 7) * 256 + (ng & 127) + (MAP == 2 ? 128 : 0));
        *(GAS v4u*)(WT + (size_t)row * K + k0 + 8 * c) = o;
        if (cs) {
            float sc = (bflo(o.x) + bfhi(o.x)) + (bflo(o.y) + bfhi(o.y)) + (bflo(o.z) + bfhi(o.z)) + (bflo(o.w) + bfhi(o.w));
            sc += __shfl_xor(sc, 1); sc += __shfl_xor(sc, 2); sc += __shfl_xor(sc, 4);
            sb += __shfl_xor(sb, 1); sb += __shfl_xor(sb, 2); sb += __shfl_xor(sb, 4);
            if (c == 0) { atomicAdd(cs + row, sc); atomicAdd(bw + row, sb); }
        } }
    LDS_WAIT(); asm volatile("" ::: "memory");
}

struct Args { const float* in[20]; float* out; unsigned char* ws; int ph_lo, ph_hi, flags, pad; };

__device__ __forceinline__ void p0_prologue(const Frame& F, const Args& a) {
    unsigned char* ws = a.ws;
    LAS float* scr = (LAS float*)(F.lds + RING_OFF + F.wave * 16384);
    const int gw = F.vcu * NWAVES + F.wave, NGW = F.G * NWAVES;
    const float* w_in = a.in[2]; const float* w_out = a.in[9]; const float* wg = a.in[12]; const float* wu = a.in[13]; const float* wd = a.in[14]; const float* wpp = a.in[17]; const float* wpg = a.in[18];
    const float* ln1_g = a.in[10]; const float* ln1_b = a.in[11]; const float* ln2_g = a.in[15]; const float* ln2_b = a.in[16];
    float* cs_gu = (float*)(ws + WS_CTL + CTL_CS_GU); float* bw_gu = (float*)(ws + WS_CTL + CTL_BW_GU); float* cs_pg = (float*)(ws + WS_CTL + CTL_CS_PG); float* bw_pg = (float*)(ws + WS_CTL + CTL_BW_PG);
    constexpr int I_IN = (D / 64) * (NIN / 32), I_OUT = (D / 64) * (D / 32), I_G = (D / 64) * (FF / 32), I_DN = (FF / 64) * (D / 32), I_PG = I_OUT, I_PP = (PLE / 64) * (D / 32);
    constexpr int NITEMS = I_IN + I_OUT + 2 * I_G + I_DN + I_PG + I_PP;
    for (int it = gw; it < NITEMS; it += NGW) {
        int r = it;
        if (r < I_IN) { p0_transpose_item<3>(w_in, D, PROJW, NIN / 32, (bf16*)(ws + WS_WIN), nullptr, nullptr, nullptr, nullptr, scr, r, F.lane); continue; } r -= I_IN;
        if (r < I_OUT) { p0_transpose_item<0>(w_out, D, D, D / 32, (bf16*)(ws + WS_WOUT), nullptr, nullptr, nullptr, nullptr, scr, r, F.lane); continue; } r -= I_OUT;
        if (r < I_G) { p0_transpose_item<1>(wg, D, FF, FF / 32, (bf16*)(ws + WS_WGU), ln1_g, ln1_b, cs_gu, bw_gu, scr, r, F.lane); continue; } r -= I_G;
        if (r < I_G) { p0_transpose_item<2>(wu, D, FF, FF / 32, (bf16*)(ws + WS_WGU), ln1_g, ln1_b, cs_gu, bw_gu, scr, r, F.lane); continue; } r -= I_G;
        if (r < I_DN) { p0_transpose_item<0>(wd, FF, D, D / 32, (bf16*)(ws + WS_WDN), nullptr, nullptr, nullptr, nullptr, scr, r, F.lane); continue; } r -= I_DN;
        if (r < I_PG) { p0_transpose_item<0>(wpg, D, D, D / 32, (bf16*)(ws + WS_WPG), ln2_g, ln2_b, cs_pg, bw_pg, scr, r, F.lane); continue; } r -= I_PG;
        p0_transpose_item<0>(wpp, PLE, D, D / 32, (bf16*)(ws + WS_WPP), nullptr, nullptr, nullptr, nullptr, scr, r, F.lane);
    }
    if (gw == 0) { const float* lg = a.in[4]; float* oml = (float*)(ws + WS_OML);
        for (int c = F.lane; c < 512; c += 64) { const float l0 = lg[c], l1 = lg[512 + c]; const float mx = fmaxf(l0, l1); const float e0 = __expf(l0 - mx), e1 = __expf(l1 - mx); oml[c] = e1 / (e0 + e1); } }
    {
        const float* x = a.in[0]; const float* p = a.in[1]; const float* b_in = a.in[3];
        bf16* XB = (bf16*)(ws + WS_XB); bf16* PB = (bf16*)(ws + WS_PB); float* GATES = (float*)(ws + WS_GATES);
        f32x4 wl[2][8][2];
#pragma unroll
        for (int j = 0; j < 2; ++j)
#pragma unroll
            for (int e = 0; e < 8; ++e) { const float* wp = w_in + (size_t)(8 * F.lane + 512 * j + e) * PROJW + NIN; wl[j][e][0] = *(const f32x4*)wp; wl[j][e][1] = *(const f32x4*)(wp + 4); }
        const float bsel = b_in[NIN + (F.lane >> 3)];
        f32x4 na[2][2], npv;
        { const int m0 = gw < M ? gw : 0; const float* xr = x + (size_t)m0 * D;
#pragma unroll
          for (int j = 0; j < 2; ++j) { na[j][0] = __builtin_nontemporal_load((const f32x4*)(xr + 8 * F.lane + 512 * j)); na[j][1] = __builtin_nontemporal_load((const f32x4*)(xr + 8 * F.lane + 512 * j + 4)); }
          npv = __builtin_nontemporal_load((const f32x4*)(p + (size_t)m0 * PLE + 4 * F.lane)); }
        for (int m = gw; m < M; m += NGW) {
            f32x4 ca[2][2]; const f32x4 pv = npv;
#pragma unroll
            for (int j = 0; j < 2; ++j) { ca[j][0] = na[j][0]; ca[j][1] = na[j][1]; }
            { const int mn = (m + NGW < M) ? (m + NGW) : m; const float* xr = x + (size_t)mn * D;
#pragma unroll
              for (int j = 0; j < 2; ++j) { na[j][0] = __builtin_nontemporal_load((const f32x4*)(xr + 8 * F.lane + 512 * j)); na[j][1] = __builtin_nontemporal_load((const f32x4*)(xr + 8 * F.lane + 512 * j + 4)); }
              npv = __builtin_nontemporal_load((const f32x4*)(p + (size_t)mn * PLE + 4 * F.lane)); }
            f32x4 g0 = {0.f, 0.f, 0.f, 0.f}, g1 = {0.f, 0.f, 0.f, 0.f};
#pragma unroll
            for (int j = 0; j < 2; ++j) { const f32x4 a0 = ca[j][0], a1 = ca[j][1];
                v4u o; o.x = pk2(a0[0], a0[1]); o.y = pk2(a0[2], a0[3]); o.z = pk2(a1[0], a1[1]); o.w = pk2(a1[2], a1[3]);
                *(GAS v4u*)(XB + (size_t)m * D + 8 * F.lane + 512 * j) = o;
#pragma unroll
                for (int e = 0; e < 4; ++e) { g0 += wl[j][e][0] * a0[e]; g1 += wl[j][e][1] * a0[e]; g0 += wl[j][4 + e][0] * a1[e]; g1 += wl[j][4 + e][1] * a1[e]; } }
            const bool b5 = (F.lane & 32) != 0, b4 = (F.lane & 16) != 0, b3 = (F.lane & 8) != 0;
            float k4[4];
#pragma unroll
            for (int e = 0; e < 4; ++e) { const float keep = b5 ? g1[e] : g0[e], send = b5 ? g0[e] : g1[e]; k4[e] = keep + __shfl_xor(send, 32); }
            float k2[2];
#pragma unroll
            for (int e = 0; e < 2; ++e) { const float keep = b4 ? k4[2 + e] : k4[e], send = b4 ? k4[e] : k4[2 + e]; k2[e] = keep + __shfl_xor(send, 16); }
            float k1; { const float keep = b3 ? k2[1] : k2[0], send = b3 ? k2[0] : k2[1]; k1 = keep + __shfl_xor(send, 8); }
            k1 += __shfl_xor(k1, 4); k1 += __shfl_xor(k1, 2); k1 += __shfl_xor(k1, 1);
            if ((F.lane & 7) == 0) GATES[(size_t)m * 8 + (F.lane >> 3)] = k1 + bsel;
            v2u po; po.x = pk2(pv[0], pv[1]); po.y = pk2(pv[2], pv[3]);
            *(GAS v2u*)(PB + (size_t)m * PLE + 4 * F.lane) = po;
        }
    }
}

namespace mx {
typedef short s16x4 __attribute__((ext_vector_type(4)));
typedef short bf16x8 __attribute__((ext_vector_type(8)));
typedef short v4i16_t __attribute__((ext_vector_type(4)));
constexpr int NCH = 8;
constexpr int NSC = SEQ / (64 * NCH);
constexpr int NUNIT = 16 * NSC;
constexpr int L_QT = 0, L_KT = 16384, L_V = 32768, L_G = 49152, L_IMG = 65536  , L_XT = 131072, L_PART = 140288  ;
constexpr int XT_STRIDE = 144;
__device__ __forceinline__ unsigned off_b(unsigned row, unsigned ch) { return 256u * row + 16u * (ch ^ (((row & 3) << 2) | ((row >> 2) & 3))); }
__device__ __forceinline__ unsigned row_addr16(unsigned lane, unsigned rb, unsigned s) { return off_b((lane & 15) + 16 * rb, 4 * s + (lane >> 4)); }
__device__ __forceinline__ unsigned tr_addr16(unsigned lane, unsigned c, unsigned ks, unsigned t) { const unsigned g = lane >> 4, q = (lane & 15) >> 2, p = lane & 3;
    return off_b(32 * ks + 8 * g + 4 * t + q, 2 * c + (p >> 1)) + 8 * (p & 1); }
__device__ __forceinline__ unsigned perm_addr16(unsigned lane, unsigned rb, unsigned ks, unsigned half) { const unsigned g = lane >> 4;
    return off_b((lane & 15) + 16 * rb, 4 * ks + 2 * half + (g >> 1)) + 8 * (g & 1); }
__device__ __forceinline__ bf16x8 ld128(LAS unsigned char* L, unsigned off) { return *(const LAS bf16x8*)(L + off); }
__device__ __forceinline__ s16x4 ld64(LAS unsigned char* L, unsigned off) { return *(const LAS s16x4*)(L + off); }
__device__ __forceinline__ s16x4 ldtr(LAS unsigned char* L, unsigned off) { return __builtin_bit_cast(s16x4, __builtin_amdgcn_ds_read_tr16_b64_v4i16((LAS v4i16_t*)(L + off))); }
using pg8::cvt_pk_bf16;
__device__ __forceinline__ bf16x8 cat(s16x4 lo, s16x4 hi) { return (bf16x8){lo[0], lo[1], lo[2], lo[3], hi[0], hi[1], hi[2], hi[3]}; }
__device__ __forceinline__ bf16x8 pack8(const f32x4& a, const f32x4& b) { v4u w; w.x = cvt_pk_bf16(a[0], a[1]); w.y = cvt_pk_bf16(a[2], a[3]); w.z = cvt_pk_bf16(b[0], b[1]); w.w = cvt_pk_bf16(b[2], b[3]); return __builtin_bit_cast(bf16x8, w); }
#define MX_MFMA(a, b, c) __builtin_amdgcn_mfma_f32_16x16x32_bf16((a), (b), (c), 0, 0, 0)

template <int NKS>
__device__ __forceinline__ void x_tile(LAS unsigned char* L, LAS unsigned char* I, int lane, int sb, int tb) {
    f32x4 x = {0.f, 0.f, 0.f, 0.f};
#pragma unroll
    for (int ks = 0; ks < NKS; ++ks) x = MX_MFMA(ld128(I + L_KT, row_addr16(lane, sb, ks)), ld128(I + L_QT, row_addr16(lane, tb, ks)), x);
    const int g = lane >> 4, l15 = lane & 15;
#ifdef DBG_T5
    x = (f32x4){1.f, 1.f, 1.f, 1.f};
#endif
    if (sb == tb) {
#pragma unroll
        for (int i = 0; i < 4; ++i) x[i] = (4 * g + i <= l15) ? x[i] : 0.f;
    }
    v2u w; w.x = cvt_pk_bf16(x[0], x[1]); w.y = cvt_pk_bf16(x[2], x[3]);
    *(LAS v2u*)(L + L_XT + (16 * tb + l15) * XT_STRIDE + (16 * sb + 4 * g) * 2) = w;
}
template <int NKS>
__device__ __forceinline__ void x_all(LAS unsigned char* L, LAS unsigned char* I, int lane, int w) {
    switch (w) {
        case 0: x_tile<NKS>(L, I, lane, 0, 0); x_tile<NKS>(L, I, lane, 2, 3); break;
        case 1: x_tile<NKS>(L, I, lane, 0, 1); x_tile<NKS>(L, I, lane, 3, 3); break;
        case 2: x_tile<NKS>(L, I, lane, 1, 1); break;
        case 3: x_tile<NKS>(L, I, lane, 0, 2); break;
        case 4: x_tile<NKS>(L, I, lane, 1, 2); break;
        case 5: x_tile<NKS>(L, I, lane, 2, 2); break;
        case 6: x_tile<NKS>(L, I, lane, 0, 3); break;
        default: x_tile<NKS>(L, I, lane, 1, 3); break;
    }
}
__device__ __forceinline__ void x_zero(LAS unsigned char* L, int tid) {
    if (tid < 128) { const int which = tid >> 6, e = tid & 63, t = (which ? 32 : 0) + (e >> 2), s = (which ? 48 : 16) + 4 * (e & 3);
        v2u z; z.x = 0u; z.y = 0u; *(LAS v2u*)(L + L_XT + t * XT_STRIDE + s * 2) = z; }
}
__device__ __forceinline__ void out_store(bf16* orow, const f32x4 (&O)[4], const float (&scale)[4], const f32x4& gn, const v2u (&gw)[4]) {
#pragma unroll
    for (int tb = 0; tb < 4; ++tb) { const float r = scale[tb];
        v2u ww; ww.x = cvt_pk_bf16(O[tb][0] * r * gn[0] * bflo(gw[tb].x), O[tb][1] * r * gn[1] * bfhi(gw[tb].x)); ww.y = cvt_pk_bf16(O[tb][2] * r * gn[2] * bflo(gw[tb].y), O[tb][3] * r * gn[3] * bfhi(gw[tb].y));
        *(GAS v2u*)(orow + (size_t)(16 * tb) * D) = ww; }
}
template <bool NT> __device__ __forceinline__ v4u ldg16(const bf16* p) { return NT ? __builtin_nontemporal_load((const v4u*)p) : *(const GAS v4u*)p; }
#define MX_BAR() do { asm volatile("s_waitcnt lgkmcnt(0)" ::: "memory"); __builtin_amdgcn_s_barrier(); asm volatile("" ::: "memory"); } while (0)
constexpr int L_ERL = 144384;
constexpr int L_CW = 146432;
constexpr int L_GT = 148992;
constexpr int L_DEN = 153344;
constexpr int L_NST = 153856;

template <bool FULL>
__device__ __forceinline__ void hg_unit(const Frame& F, const Args& a, int uid) {
    unsigned char* ws = a.ws; LAS unsigned char* L = F.lds;
    const int tid = F.tid, w = F.wave;
    const int b = uid / (4 * NSC), h = (uid / NSC) & 3, sc = uid % NSC;
    const size_t row0 = (size_t)b * SEQ + (size_t)sc * (64 * NCH);
    const bf16* UQ = (const bf16*)(ws + WS_U + UO_Q) + (size_t)h * M * 128; const bf16* UK = (const bf16*)(ws + WS_U + UO_K) + (size_t)h * M * 128;
    const bf16* UV = (const bf16*)(ws + WS_U + UO_V) + (size_t)h * M * 128; const bf16* UG = (const bf16*)(ws + WS_U + UO_G) + (size_t)h * M * 128; const bf16* EQ = (const bf16*)(ws + WS_LOGF) + (size_t)h * M * 128;
    const float* ER = (const float*)(ws + WS_ER); const float* EL = (const float*)(ws + WS_EL);
    float* SST = (float*)(ws + (FULL ? WS_HGI : WS_HGS)) + (size_t)uid * 16384;
    bf16* OB = (bf16*)a.out;
    const int prow0 = tid >> 4, pch = tid & 15, prow1 = prow0 + 32;
    v4u rk[2], rv[2], rq[2], rg[2]; float rer = 0.f;
#define HG_LOAD(c) do { const size_t rowc_ = row0 + 64 * (c); \
        _Pragma("unroll") for (int i2 = 0; i2 < 2; ++i2) { const size_t eo = (rowc_ + (i2 ? prow1 : prow0)) * 128 + 8 * pch; \
            rk[i2] = ldg16<FULL>(UK + eo); rv[i2] = ldg16<FULL>(UV + eo); \
            if (FULL) { rq[i2] = ldg16<true>(UQ + eo); rg[i2] = ldg16<true>(UG + eo); } } \
        if (tid < 256) rer = ((tid < 128) ? ER : EL)[(rowc_ >> 6) * 512 + h * 128 + (tid & 127)]; } while (0)
    HG_LOAD(0);
    f32x4 S[8];
    { const int lane = F.lane;
#pragma unroll
      for (int db = 0; db < 8; ++db) S[db] = FULL ? __builtin_nontemporal_load((const f32x4*)(SST + ((w * 8 + db) * 64 + lane) * 4)) : (f32x4){0.f, 0.f, 0.f, 0.f}; }
    f32x4 gn = {0.f, 0.f, 0.f, 0.f};
    if (FULL) { gn = *(const f32x4*)(a.in[7] + h * 128 + 16 * w + 4 * (F.lane >> 4)); x_zero(L, tid); }
    asm volatile("" : "+v"(gn));
#define HG_WRITE(P) do { LAS unsigned char* I_ = L + (P) * L_IMG; \
        _Pragma("unroll") for (int i2 = 0; i2 < 2; ++i2) { const unsigned o = off_b(i2 ? prow1 : prow0, pch); \
            *(LAS v4u*)(I_ + L_KT + o) = rk[i2]; *(LAS v4u*)(I_ + L_V + o) = rv[i2]; \
            if (FULL) { *(LAS v4u*)(I_ + L_G + o) = rg[i2]; *(LAS v4u*)(I_ + L_QT + o) = rq[i2]; } } \
        if (tid < 256) *(LAS float*)(L + L_ERL + (P) * 1024 + tid * 4) = rer; } while (0)
    HG_WRITE(0); HG_LOAD(1);
    MX_BAR();
    for (int c = 0; c < NCH; ++c) {
        const size_t rowc = row0 + 64 * c; const int p = c & 1;
        int lane = F.lane; asm volatile("" : "+v"(lane));
        const int g = lane >> 4, l15 = lane & 15;
        LAS unsigned char* I = L + p * L_IMG; LAS unsigned char* E = L + L_ERL + p * 1024;
        if (FULL) x_all<4>(L, I, lane, w);
        __builtin_amdgcn_sched_barrier(0);
        if (c < NCH - 1) { HG_WRITE(p ^ 1); if (c < NCH - 2) HG_LOAD(c + 2); }
        __builtin_amdgcn_sched_barrier(0);
#pragma unroll
        for (int db = 0; db < 8; ++db) S[db] *= *(const LAS f32x4*)(E + (16 * db + 4 * g) * 4);
        s16x4 vlo[2], vhi[2];
#pragma unroll
        for (int ks = 0; ks < 2; ++ks) { vlo[ks] = ldtr(I + L_V, tr_addr16(lane, w, ks, 0)); vhi[ks] = ldtr(I + L_V, tr_addr16(lane, w, ks, 1)); }
        f32x4 O[4];
        if (FULL) {
#pragma unroll
            for (int tb = 0; tb < 4; ++tb) O[tb] = (f32x4){0.f, 0.f, 0.f, 0.f};
#pragma unroll
            for (int ks = 0; ks < 4; ++ks) { const bf16x8 sa = pack8(S[2 * ks], S[2 * ks + 1]);
#pragma unroll
                for (int tb = 0; tb < 4; ++tb) O[tb] = MX_MFMA(sa, cat(ld64(I + L_QT, perm_addr16(lane, tb, ks, 0)), ld64(I + L_QT, perm_addr16(lane, tb, ks, 1))), O[tb]); }
        }
#pragma unroll
        for (int db = 0; db < 8; ++db) {
#pragma unroll
            for (int ks = 0; ks < 2; ++ks) S[db] = MX_MFMA(cat(ldtr(I + L_KT, tr_addr16(lane, db, ks, 0)), ldtr(I + L_KT, tr_addr16(lane, db, ks, 1))), cat(vlo[ks], vhi[ks]), S[db]);
            S[db] *= *(const LAS f32x4*)(E + (128 + 16 * db + 4 * g) * 4); }
        MX_BAR();
        if (FULL) {
            v2u gw[4];
#pragma unroll
            for (int tb = 0; tb < 4; ++tb) gw[tb] = *(const LAS v2u*)(I + L_G + off_b(16 * tb + l15, 2 * w + (g >> 1)) + 8 * (g & 1));
#pragma unroll
            for (int tb = 0; tb < 4; ++tb)
#pragma unroll
                for (int ks = 0; ks < 2; ++ks) if (ks <= (tb >> 1))
                    O[tb] = MX_MFMA(cat(vlo[ks], vhi[ks]), *(const LAS bf16x8*)(L + L_XT + (16 * tb + l15) * XT_STRIDE + (32 * ks + 8 * g) * 2), O[tb]);
#pragma unroll
            for (int tb = 0; tb < 4; ++tb) { float ss = (O[tb][0] * O[tb][0] + O[tb][1] * O[tb][1]) + (O[tb][2] * O[tb][2] + O[tb][3] * O[tb][3]);
                ss += __shfl_xor(ss, 16); ss += __shfl_xor(ss, 32);
                if (g == 0) *(LAS float*)(L + L_PART + (p * 512 + w * 64 + 16 * tb + l15) * 4) = ss; }
            MX_BAR();
            float scale[4];
#pragma unroll
            for (int tb = 0; tb < 4; ++tb) { float tot = 0.f;
#pragma unroll
                for (int ww = 0; ww < 8; ++ww) tot += *(const LAS float*)(L + L_PART + (p * 512 + ww * 64 + 16 * tb + l15) * 4);
                scale[tb] = rsqrtf(tot * (1.0f / 128.0f) + RMS_EPS); }
            out_store(OB + (rowc + l15) * D + h * 128 + 16 * w + 4 * g, O, scale, gn, gw);
        }
    }
#undef HG_WRITE
#undef HG_LOAD
    if (!FULL) {
        const int lane = F.lane;
#pragma unroll
        for (int db = 0; db < 8; ++db) *(f32x4*)(SST + ((w * 8 + db) * 64 + lane) * 4) = S[db];
        if (tid < 128) { float pr = 1.f;
            for (int c = 0; c < NCH; ++c) { const size_t cidx = (row0 >> 6) + c; pr *= ER[cidx * 512 + h * 128 + tid] * EL[cidx * 512 + h * 128 + tid]; }
            ((float*)(ws + WS_ASC))[(size_t)uid * 128 + tid] = pr; }
    }
    MX_BAR();
}

template <bool FULL>
__device__ __forceinline__ void ml_unit(const Frame& F, const Args& a, int uid) {
    unsigned char* ws = a.ws; LAS unsigned char* L = F.lds;
    const int tid = F.tid, w = F.wave;
    const int b = uid / (4 * NSC), h = (uid / NSC) & 3, sc = uid % NSC;
    const size_t row0 = (size_t)b * SEQ + (size_t)sc * (64 * NCH);
    const bf16* MQ = (const bf16*)(ws + WS_U + UO_MQ) + (size_t)h * M * 64; const bf16* MK = (const bf16*)(ws + WS_U + UO_MK) + (size_t)h * M * 64;
    const bf16* MV = (const bf16*)(ws + WS_U + UO_MV) + (size_t)h * M * 128; const bf16* MO = (const bf16*)(ws + WS_U + UO_MO) + (size_t)h * M * 128; const float* GATES = (const float*)(ws + WS_GATES);
    float* SST = (float*)(ws + (FULL ? WS_MLCI : WS_MLC)) + (size_t)uid * 8192;
    float* MLS = (float*)(ws + WS_MLS) + (size_t)uid * 4; float* MLN = (float*)(ws + (FULL ? WS_MLNI : WS_MLN)) + (size_t)uid * 64;
    bf16* OB = (bf16*)a.out;
    LAS float* GT = (LAS float*)(L + L_GT); LAS float* CW = (LAS float*)(L + L_CW); LAS float* DEN = (LAS float*)(L + L_DEN); LAS float* NST = (LAS float*)(L + L_NST);
    const int crow = tid >> 3, cch = tid & 7;
    const int prow0 = tid >> 4, pch = tid & 15, prow1 = prow0 + 32;
    v4u xk[4], xq[4], rv[2], rg[2];
#define ML_LOAD(c) do { const long tseq0_ = (long)sc * (64 * NCH) + 64 * (c) + crow - 3; \
        _Pragma("unroll") for (int k = 0; k < 4; ++k) { const long ts = tseq0_ + k; xk[k] = (v4u){0u, 0u, 0u, 0u}; xq[k] = (v4u){0u, 0u, 0u, 0u}; \
            if (ts >= 0) { const size_t eo = ((size_t)b * SEQ + ts) * 64 + 8 * cch; xk[k] = ldg16<FULL>(MK + eo); if (FULL) xq[k] = ldg16<true>(MQ + eo); } } \
        _Pragma("unroll") for (int i2 = 0; i2 < 2; ++i2) { const size_t eo = (row0 + 64 * (c) + (i2 ? prow1 : prow0)) * 128 + 8 * pch; rv[i2] = ldg16<FULL>(MV + eo); if (FULL) rg[i2] = ldg16<true>(MO + eo); } } while (0)
    ML_LOAD(0);
    f32x4 S[4];
    { const int lane = F.lane;
#pragma unroll
      for (int db = 0; db < 4; ++db) S[db] = FULL ? __builtin_nontemporal_load((const f32x4*)(SST + ((w * 4 + db) * 64 + lane) * 4)) : (f32x4){0.f, 0.f, 0.f, 0.f}; }
    if (tid < 64) NST[tid] = FULL ? MLN[tid] : 0.f;
    if (tid >= 64 && tid < 192) { const int cc = tid - 64; const float* cw = a.in[5]; const float* cb = a.in[6]; const int gc = (cc < 64) ? (h * 64 + cc) : (256 + h * 64 + cc - 64);
#pragma unroll
        for (int k = 0; k < 4; ++k) CW[k * 128 + cc] = cw[k * 512 + gc];
        CW[512 + cc] = cb[gc]; }
    f32x4 gn = {0.f, 0.f, 0.f, 0.f};
    if (FULL) { gn = *(const f32x4*)(a.in[8] + h * 128 + 16 * w + 4 * (F.lane >> 4)); x_zero(L, tid); }
    asm volatile("" : "+v"(gn));
    if (w == 7) { const int lane = F.lane;
        float m_run = FULL ? ((const float*)(ws + WS_MLI))[uid] : -1.0e30f, gsum = 0.f;
        float igv[NCH], fgv[NCH];
#pragma unroll
        for (int c = 0; c < NCH; ++c) { igv[c] = GATES[(row0 + 64 * c + lane) * 8 + h]; fgv[c] = GATES[(row0 + 64 * c + lane) * 8 + 4 + h]; }
#pragma unroll
        for (int c = 0; c < NCH; ++c) {
            const float ig = igv[c], fgp = fgv[c];
            float gc = fminf(fgp, 0.f) - __logf(1.0f + __expf(-fabsf(fgp)));
#define ML_DPPF(x, old, ctrl, rmask, bc) __builtin_bit_cast(float, __builtin_amdgcn_update_dpp(__builtin_bit_cast(int, (old)), __builtin_bit_cast(int, (x)), (ctrl), (rmask), 0xF, (bc)))
            gc += ML_DPPF(gc, 0.f, 0x111, 0xF, true); gc += ML_DPPF(gc, 0.f, 0x112, 0xF, true); gc += ML_DPPF(gc, 0.f, 0x114, 0xF, true); gc += ML_DPPF(gc, 0.f, 0x118, 0xF, true);
            gc += ML_DPPF(gc, 0.f, 0x142, 0xA, false); gc += ML_DPPF(gc, 0.f, 0x143, 0xC, false);
            const float av = ig - gc; float amax = av;
            amax = fmaxf(amax, ML_DPPF(amax, amax, 0x111, 0xF, false)); amax = fmaxf(amax, ML_DPPF(amax, amax, 0x112, 0xF, false)); amax = fmaxf(amax, ML_DPPF(amax, amax, 0x114, 0xF, false)); amax = fmaxf(amax, ML_DPPF(amax, amax, 0x118, 0xF, false));
            amax = fmaxf(amax, ML_DPPF(amax, amax, 0x142, 0xA, false)); amax = fmaxf(amax, ML_DPPF(amax, amax, 0x143, 0xC, false));
            amax = __builtin_bit_cast(float, __builtin_amdgcn_readlane(__builtin_bit_cast(int, amax), 63));
#undef ML_DPPF
            const float mu = fmaxf(m_run, amax);
            GT[c * 128 + lane] = __expf(av - mu); GT[c * 128 + 64 + lane] = __expf(-(gc + mu));
            const float gl = __builtin_bit_cast(float, __builtin_amdgcn_readlane(__builtin_bit_cast(int, gc), 63));
            if (lane == 0) { GT[NCH * 128 + 4 * c] = __expf(m_run - mu); }
            m_run = gl + mu; gsum += gl; }
        if (lane == 0) { GT[NCH * 132] = m_run; GT[NCH * 132 + 1] = gsum; } }
    MX_BAR();
#define ML_WRITE(P, CC) do { LAS unsigned char* I_ = L + (P) * L_IMG; \
        const LAS float* cq = CW + 8 * cch; const LAS float* ck = CW + 64 + 8 * cch; \
        const unsigned o = off_b(crow, cch); \
        { f32x4 kacc0 = *(const LAS f32x4*)(ck + 512), kacc1 = *(const LAS f32x4*)(ck + 516); \
          _Pragma("unroll") for (int k = 0; k < 4; ++k) { const f32x4 wk0 = *(const LAS f32x4*)(ck + 128 * k), wk1 = *(const LAS f32x4*)(ck + 128 * k + 4); \
            kacc0[0] += wk0[0] * bflo(xk[k].x); kacc0[1] += wk0[1] * bfhi(xk[k].x); kacc0[2] += wk0[2] * bflo(xk[k].y); kacc0[3] += wk0[3] * bfhi(xk[k].y); \
            kacc1[0] += wk1[0] * bflo(xk[k].z); kacc1[1] += wk1[1] * bfhi(xk[k].z); kacc1[2] += wk1[2] * bflo(xk[k].w); kacc1[3] += wk1[3] * bfhi(xk[k].w); } \
          const float scl = GT[(CC) * 128 + crow]; \
          _Pragma("unroll") for (int e = 0; e < 4; ++e) { kacc0[e] = fsilu(kacc0[e]) * scl; kacc1[e] = fsilu(kacc1[e]) * scl; } \
          *(LAS bf16x8*)(I_ + L_KT + o) = pack8(kacc0, kacc1); } \
        __builtin_amdgcn_sched_barrier(0); \
        if (FULL) { f32x4 qacc0 = *(const LAS f32x4*)(cq + 512), qacc1 = *(const LAS f32x4*)(cq + 516); \
          _Pragma("unroll") for (int k = 0; k < 4; ++k) { const f32x4 wq0 = *(const LAS f32x4*)(cq + 128 * k), wq1 = *(const LAS f32x4*)(cq + 128 * k + 4); \
            qacc0[0] += wq0[0] * bflo(xq[k].x); qacc0[1] += wq0[1] * bfhi(xq[k].x); qacc0[2] += wq0[2] * bflo(xq[k].y); qacc0[3] += wq0[3] * bfhi(xq[k].y); \
            qacc1[0] += wq1[0] * bflo(xq[k].z); qacc1[1] += wq1[1] * bfhi(xq[k].z); qacc1[2] += wq1[2] * bflo(xq[k].w); qacc1[3] += wq1[3] * bfhi(xq[k].w); } \
          _Pragma("unroll") for (int e = 0; e < 4; ++e) { qacc0[e] = fsilu(qacc0[e]) * 0.125f; qacc1[e] = fsilu(qacc1[e]) * 0.125f; } \
          *(LAS bf16x8*)(I_ + L_QT + o) = pack8(qacc0, qacc1); } \
        __builtin_amdgcn_sched_barrier(0); \
        _Pragma("unroll") for (int i2 = 0; i2 < 2; ++i2) { const unsigned o2 = off_b(i2 ? prow1 : prow0, pch); *(LAS v4u*)(I_ + L_V + o2) = rv[i2]; if (FULL) *(LAS v4u*)(I_ + L_G + o2) = rg[i2]; } } while (0)
    ML_WRITE(0, 0); ML_LOAD(1);
    MX_BAR();
    for (int c = 0; c < NCH; ++c) {
        const size_t rowc = row0 + 64 * c; const int p = c & 1;
        int lane = F.lane; asm volatile("" : "+v"(lane));
        const int g = lane >> 4, l15 = lane & 15;
        LAS unsigned char* I = L + p * L_IMG;
        const float wv = GT[NCH * 128 + 4 * c];
        if (FULL) x_all<2>(L, I, lane, w);
        __builtin_amdgcn_sched_barrier(0);
        if (c < NCH - 1) { ML_WRITE(p ^ 1, c + 1); if (c < NCH - 2) ML_LOAD(c + 2); }
        __builtin_amdgcn_sched_barrier(0);
#pragma unroll
        for (int db = 0; db < 4; ++db) S[db] *= wv;
        s16x4 vlo[2], vhi[2];
#pragma unroll
        for (int ks = 0; ks < 2; ++ks) { vlo[ks] = ldtr(I + L_V, tr_addr16(lane, w, ks, 0)); vhi[ks] = ldtr(I + L_V, tr_addr16(lane, w, ks, 1)); }
        __builtin_amdgcn_sched_barrier(0);
        f32x4 O[4];
        if (FULL) {
#pragma unroll
            for (int tb = 0; tb < 4; ++tb) O[tb] = (f32x4){0.f, 0.f, 0.f, 0.f};
#pragma unroll
            for (int ks = 0; ks < 2; ++ks) { const bf16x8 sa = pack8(S[2 * ks], S[2 * ks + 1]);
#pragma unroll
                for (int tb = 0; tb < 4; ++tb) O[tb] = MX_MFMA(sa, cat(ld64(I + L_QT, perm_addr16(lane, tb, ks, 0)), ld64(I + L_QT, perm_addr16(lane, tb, ks, 1))), O[tb]); }
        }
        __builtin_amdgcn_sched_barrier(0);
#pragma unroll
        for (int db = 0; db < 4; ++db)
#pragma unroll
            for (int ks = 0; ks < 2; ++ks) S[db] = MX_MFMA(cat(ldtr(I + L_KT, tr_addr16(lane, db, ks, 0)), ldtr(I + L_KT, tr_addr16(lane, db, ks, 1))), cat(vlo[ks], vhi[ks]), S[db]);
        __builtin_amdgcn_sched_barrier(0);
        if (w == 1) { const int rg = lane >> 3, ch = lane & 7; float cs[8] = {0.f, 0.f, 0.f, 0.f, 0.f, 0.f, 0.f, 0.f};
#pragma unroll
            for (int r8 = 0; r8 < 8; ++r8) { const v4u kv = *(const LAS v4u*)(I + L_KT + off_b(8 * rg + r8, ch));
                cs[0] += bflo(kv.x); cs[1] += bfhi(kv.x); cs[2] += bflo(kv.y); cs[3] += bfhi(kv.y); cs[4] += bflo(kv.z); cs[5] += bfhi(kv.z); cs[6] += bflo(kv.w); cs[7] += bfhi(kv.w); }
#pragma unroll
            for (int e = 0; e < 8; ++e) { cs[e] += __shfl_xor(cs[e], 8); cs[e] += __shfl_xor(cs[e], 16); cs[e] += __shfl_xor(cs[e], 32); }
            if (lane < 8) {
#pragma unroll
                for (int e = 0; e < 8; ++e) NST[(p ^ 1) * 64 + 8 * lane + e] = wv * NST[p * 64 + 8 * lane + e] + cs[e]; } }
        MX_BAR();
        if (FULL) {
            v2u gw[4];
#pragma unroll
            for (int tb = 0; tb < 4; ++tb) gw[tb] = *(const LAS v2u*)(I + L_G + off_b(16 * tb + l15, 2 * w + (g >> 1)) + 8 * (g & 1));
#pragma unroll
            for (int tb = 0; tb < 4; ++tb)
#pragma unroll
                for (int ks = 0; ks < 2; ++ks) if (ks <= (tb >> 1))
                    O[tb] = MX_MFMA(cat(vlo[ks], vhi[ks]), *(const LAS bf16x8*)(L + L_XT + (16 * tb + l15) * XT_STRIDE + (32 * ks + 8 * g) * 2), O[tb]);
            if (w == 1) { float sx = 0.f, qn = 0.f;
#pragma unroll
                for (int ch = 0; ch < 8; ++ch) { const v4u xv = *(const LAS v4u*)(L + L_XT + lane * XT_STRIDE + 16 * ch);
                    if (ch < 2 * ((lane >> 4) + 1)) sx += (bflo(xv.x) + bfhi(xv.x)) + (bflo(xv.y) + bfhi(xv.y)) + (bflo(xv.z) + bfhi(xv.z)) + (bflo(xv.w) + bfhi(xv.w));
                    const v4u qv = *(const LAS v4u*)(I + L_QT + off_b(lane, ch)); const LAS float* nn = NST + p * 64 + 8 * ch;
                    qn += bflo(qv.x) * nn[0] + bfhi(qv.x) * nn[1] + bflo(qv.y) * nn[2] + bfhi(qv.y) * nn[3] + bflo(qv.z) * nn[4] + bfhi(qv.z) * nn[5] + bflo(qv.w) * nn[6] + bfhi(qv.w) * nn[7]; }
                DEN[p * 64 + lane] = sx + wv * qn; }
#pragma unroll
            for (int tb = 0; tb < 4; ++tb) { float ss = (O[tb][0] * O[tb][0] + O[tb][1] * O[tb][1]) + (O[tb][2] * O[tb][2] + O[tb][3] * O[tb][3]);
                ss += __shfl_xor(ss, 16); ss += __shfl_xor(ss, 32);
                if (g == 0) *(LAS float*)(L + L_PART + (p * 512 + w * 64 + 16 * tb + l15) * 4) = ss; }
            MX_BAR();
            float scale[4];
#pragma unroll
            for (int tb = 0; tb < 4; ++tb) { const int t = 16 * tb + l15; float tot = 0.f;
#pragma unroll
                for (int ww = 0; ww < 8; ++ww) tot += *(const LAS float*)(L + L_PART + (p * 512 + ww * 64 + t) * 4);
                const float dd = fmaxf(fabsf(DEN[p * 64 + t]), GT[c * 128 + 64 + t]);
                scale[tb] = rsqrtf(tot * (1.0f / 128.0f) + RMS_EPS * dd * dd); }
            out_store(OB + (rowc + l15) * D + 512 + h * 128 + 16 * w + 4 * g, O, scale, gn, gw);
        }
    }
#undef ML_WRITE
#undef ML_LOAD
    if (!FULL) {
        const int lane = F.lane;
#pragma unroll
        for (int db = 0; db < 4; ++db) *(f32x4*)(SST + ((w * 4 + db) * 64 + lane) * 4) = S[db];
        if (tid < 64) MLN[tid] = NST[tid];
        if (tid == 0) { MLS[0] = GT[NCH * 132 + 1]; MLS[1] = GT[NCH * 132]; }
    }
    MX_BAR();
}

template <bool FULL>
__device__ __forceinline__ void mixer_pass(const Frame& F, const Args& a) {
    if (F.vcu & 1) {
        for (int u = F.vcu; u < NUNIT; u += F.G) ml_unit<FULL>(F, a, u);
        for (int u = F.vcu; u < NUNIT; u += F.G) hg_unit<FULL>(F, a, u);
    } else {
        for (int u = F.vcu; u < NUNIT; u += F.G) hg_unit<FULL>(F, a, u);
        for (int u = F.vcu; u < NUNIT; u += F.G) ml_unit<FULL>(F, a, u);
    }
}
__device__ __forceinline__ void scan_pass(const Frame& F, const Args& a) {
    unsigned char* ws = a.ws;
    const size_t gt = (size_t)F.vcu * (NWAVES * 64) + F.tid, GT = (size_t)F.G * (NWAVES * 64);
    const float* HGS = (const float*)(ws + WS_HGS); const float* MLSt = (const float*)(ws + WS_MLC);
    float* HGI = (float*)(ws + WS_HGI); float* MLCI = (float*)(ws + WS_MLCI); float* MLNI = (float*)(ws + WS_MLNI); float* MLI = (float*)(ws + WS_MLI);
    const float* ASC = (const float*)(ws + WS_ASC); const float* MLS = (const float*)(ws + WS_MLS); const float* MLN = (const float*)(ws + WS_MLN);
    constexpr size_t N_HG = 16 * 4096, N_MLC = 16 * 2048, N_MLN = 16 * 16;
    for (size_t e0 = gt; e0 < N_HG + N_MLC + N_MLN; e0 += GT) {
        if (e0 < N_HG) { const int bh = (int)(e0 >> 12), e4 = (int)(e0 & 4095); const int d = 16 * ((e4 >> 6) & 7) + 4 * ((e4 & 63) >> 4);
            f32x4 run = {0.f, 0.f, 0.f, 0.f};
            for (int s0 = 0; s0 < NSC; s0 += 16) { f32x4 loc[16], av[16];
#pragma unroll
                for (int k = 0; k < 16; ++k) { const size_t uid = (size_t)bh * NSC + s0 + k; loc[k] = __builtin_nontemporal_load((const f32x4*)(HGS + uid * 16384 + 4 * e4)); av[k] = *(const f32x4*)(ASC + uid * 128 + d); }
#pragma unroll
                for (int k = 0; k < 16; ++k) { const size_t uid = (size_t)bh * NSC + s0 + k; *(f32x4*)(HGI + uid * 16384 + 4 * e4) = run; run = av[k] * run + loc[k]; } }
        } else { const size_t e1 = e0 - N_HG; const bool isn = e1 >= N_MLC; const int bh = isn ? (int)((e1 - N_MLC) >> 4) : (int)(e1 >> 11), e4 = isn ? (int)((e1 - N_MLC) & 15) : (int)(e1 & 2047);
            f32x4 run = {0.f, 0.f, 0.f, 0.f}; float m = 0.f;
            for (int s0 = 0; s0 < NSC; s0 += 16) { f32x4 loc[16]; float Gv[16], mlv[16];
#pragma unroll
                for (int k = 0; k < 16; ++k) { const size_t uid = (size_t)bh * NSC + s0 + k; Gv[k] = MLS[uid * 4]; mlv[k] = MLS[uid * 4 + 1];
                    loc[k] = isn ? *(const f32x4*)(MLN + uid * 64 + 4 * e4) : __builtin_nontemporal_load((const f32x4*)(MLSt + uid * 8192 + 4 * e4)); }
#pragma unroll
                for (int k = 0; k < 16; ++k) { const size_t uid = (size_t)bh * NSC + s0 + k;
                    if (isn) *(f32x4*)(MLNI + uid * 64 + 4 * e4) = run; else *(f32x4*)(MLCI + uid * 8192 + 4 * e4) = run;
                    if (!isn && e4 == 0) MLI[uid] = m;
                    const float mn = fmaxf(m + Gv[k], mlv[k]); run = run * __expf(m + Gv[k] - mn) + loc[k] * __expf(mlv[k] - mn); m = mn; } }
        }
    }
}
}

__global__ void __launch_bounds__(NWAVES * 64, 2) hymba_fwd(Args args) {
    extern __shared__ __attribute__((aligned(16))) unsigned char lds[];
    Frame F;
    F.lds = (LAS unsigned char*)lds;
    F.tid = threadIdx.x; F.lane = F.tid & 63; F.wave = __builtin_amdgcn_readfirstlane(F.tid >> 6);
    F.G = gridDim.x; { const int bx = blockIdx.x; F.vcu = (F.G % 8 == 0) ? (bx % 8) * (F.G / 8) + bx / 8 : bx; }
    unsigned char* ws = args.ws;
    volatile LAS unsigned* MISC = (volatile LAS unsigned*)(F.lds + MISC_OFF);
    for (int u = F.tid; u < (LDS_BYTES - LDSCTL_OFF) / 4; u += NWAVES * 64) ((LAS unsigned*)(F.lds + LDSCTL_OFF))[u] = 0u;
    __syncthreads();
    XcdBarrier bar; bar.bar = (unsigned*)(ws + WS_CTL) + CW_BAR; bar.x = 0; bar.st = nullptr;
    if (N_LAUNCHES == 1) bar = xcd_barrier_post((unsigned*)(ws + WS_CTL) + CW_BAR, MISC + 8);
    const int lo = args.ph_lo, hi = args.ph_hi;
#ifndef PH_MASK
#define PH_MASK 0x1ff
#endif
#define IN(k) (((PH_MASK >> (k)) & 1) && lo <= (k) && (k) < hi)
#define BOTH(k) (IN(k) && IN((k) + 1))
#define GRID_BAR() do { if (N_LAUNCHES == 1) xcd_barrier(bar); } while (0)

    if (IN(0)) { p0_prologue(F, args); if (BOTH(0)) GRID_BAR(); }
    if (IN(1)) {
        pg8::Gemm g{(const bf16*)(ws + WS_XB), (const bf16*)(ws + WS_WIN), M, NIN, D}; pg8::StaticOrder S; S.init(M, NIN, F.G, (int)blockIdx.x);
        EpiInProj E{(bf16*)(ws + WS_U), (bf16*)(ws + WS_LOGF), (float*)(ws + WS_ER), (float*)(ws + WS_EL), args.in[3], (const float*)(ws + WS_OML)};
        pg8::gemm_phase<EpiInProj, pg8::StaticOrder, PG8_ALIGN, PG8_SP2>(F.lds + RING_OFF, g, S, E);
        if (BOTH(1)) GRID_BAR();
    }
    if (IN(2)) { mx::mixer_pass<false>(F, args); if (BOTH(2)) GRID_BAR(); }
    if (IN(3)) { mx::scan_pass(F, args);
        if (BOTH(3)) GRID_BAR(); }
    if (IN(4)) { mx::mixer_pass<true>(F, args);
        if (BOTH(4)) GRID_BAR(); }
    if (IN(5)) {
        pg8::Gemm g{(const bf16*)args.out, (const bf16*)(ws + WS_WOUT), M, D, D}; pg8::StaticOrder S; S.init(M, D, F.G, (int)blockIdx.x);
        EpiOutProj E{(const bf16*)(ws + WS_XB), (bf16*)(ws + WS_LOGF), (float*)(ws + WS_CTL + ((args.flags & 1) ? 768 * 1024 : CTL_ST1))};
        pg8::gemm_phase<EpiOutProj, pg8::StaticOrder, PG8_ALIGN, PG8_SP2>(F.lds + RING_OFF, g, S, E);
        if (BOTH(5)) GRID_BAR();
    }
    if (IN(6)) {
        pg8::Gemm g{(const bf16*)(ws + WS_LOGF), (const bf16*)(ws + WS_WGU), M, NGU, D}; pg8::StaticOrder S; S.init(M, NGU, F.G, (int)blockIdx.x);
        EpiGateUp E{(bf16*)(ws + WS_U), (const float*)(ws + WS_CTL + CTL_ST1), (const float*)(ws + WS_CTL + CTL_CS_GU), (const float*)(ws + WS_CTL + CTL_BW_GU)};
        pg8::gemm_phase<EpiGateUp, pg8::StaticOrder, PG8_ALIGN, PG8_SP2>(F.lds + RING_OFF, g, S, E);
        if (BOTH(6)) GRID_BAR();
    }
    if (IN(7)) {
        pg8::Gemm g{(const bf16*)(ws + WS_U), (const bf16*)(ws + WS_WDN), M, D, FF}; pg8::StaticOrder S; S.init(M, D, F.G, (int)blockIdx.x);
        EpiDown E{(bf16*)(ws + WS_LOGF), (const float*)(ws + WS_CTL + CTL_ST1), (float*)(ws + WS_CTL + CTL_ST2), args.in[10], args.in[11]};
        pg8::gemm_phase<EpiDown, pg8::StaticOrder, PG8_ALIGN, PG8_SP2>(F.lds + RING_OFF, g, S, E);
    }
    if (IN(8)) {
#ifndef NO_PGEMM
        {   int kp = PLE; asm volatile("" : "+s"(kp));
            pg8::Gemm g{(const bf16*)(ws + WS_PB), (const bf16*)(ws + WS_WPP), M, D, kp}; pg8::StaticOrder S; S.init(M, D, F.G, (int)blockIdx.x);
            EpiPleP E{(pg8::u32x4*)(ws + WS_XB)};
            pg8::gemm_phase<EpiPleP, pg8::StaticOrder, PG8_ALIGN, PG8_SP2>(F.lds + RING_OFF, g, S, E); }
#endif
        VM_WAIT(); __syncthreads();
        if (BOTH(7)) GRID_BAR();
#ifndef NO_FGEMM
        {   pg8::Gemm g{(const bf16*)(ws + WS_LOGF), (const bf16*)(ws + WS_WPG), M, D, D}; pg8::StaticOrder S; S.init(M, D, F.G, (int)blockIdx.x);
            EpiFinal E{args.out, (const bf16*)(ws + WS_LOGF), (const pg8::u32x4*)(ws + WS_XB), (const float*)(ws + WS_CTL + CTL_ST2), args.in[15], args.in[16], (const float*)(ws + WS_CTL + CTL_CS_PG), (const float*)(ws + WS_CTL + CTL_BW_PG), args.in[19]};
            pg8::gemm_phase<EpiFinal, pg8::StaticOrder, PG8_ALIGN, PG8_SP2>(F.lds + RING_OFF, g, S, E); }
#endif
    }
#undef IN
#undef BOTH
#undef GRID_BAR
}

extern "C" void kernel_launch(void* const* d_in, const int* in_sizes, int n_in, void* d_out, int out_size, void* d_ws, size_t ws_size, hipStream_t stream) {
    static int grid = 0;
    if (grid == 0) {
        if (n_in != 20 || in_sizes[0] != M * D || out_size != M * D || ws_size < WS_END) { fprintf(stderr, "kernel_launch: unexpected shapes: n_in %d in0 %d out %d ws %zu (need %zu)\n", n_in, n_in > 0 ? in_sizes[0] : -1, out_size, ws_size, (size_t)WS_END); grid = -1; return; }
        int dev = 0, cus = 0, per_cu = 0;
        if (hipGetDevice(&dev) != hipSuccess || hipDeviceGetAttribute(&cus, hipDeviceAttributeMultiprocessorCount, dev) != hipSuccess) { grid = -1; return; }
        if (hipFuncSetAttribute((const void*)hymba_fwd, hipFuncAttributeMaxDynamicSharedMemorySize, LDS_BYTES) != hipSuccess) { fprintf(stderr, "kernel_launch: hipFuncSetAttribute failed\n"); grid = -1; return; }
        if (hipOccupancyMaxActiveBlocksPerMultiprocessor(&per_cu, (const void*)hymba_fwd, NWAVES * 64, LDS_BYTES) != hipSuccess || per_cu < 1)
            fprintf(stderr, "kernel_launch: note: occupancy query reports %d workgroups per CU\n", per_cu);
        (void)hipGetLastError();
        grid = cus;
    }
    if (grid < 0) return;
    if (hipMemsetAsync((char*)d_ws + WS_CTL, 0, CTL_ZERO_BYTES, stream) != hipSuccess) { fprintf(stderr, "kernel_launch: memset failed\n"); return; }
    Args a{};
    for (int i = 0; i < 20; ++i) a.in[i] = (const float*)d_in[i];
    a.out = (float*)d_out; a.ws = (unsigned char*)d_ws;
    if (N_LAUNCHES == 1) { a.ph_lo = 0; a.ph_hi = NPHASE; hipLaunchKernelGGL(hymba_fwd, dim3(grid), dim3(NWAVES * 64), LDS_BYTES, stream, a); }
    else for (int li = 0; li < NPHASE; ++li) { a.ph_lo = li; a.ph_hi = li + 1;
#ifdef PROBE_PHASE
        if (li == PROBE_PHASE) { a.flags = 1; hipLaunchKernelGGL(hymba_fwd, dim3(grid), dim3(NWAVES * 64), LDS_BYTES, stream, a); a.flags = 0; }
#endif
        hipLaunchKernelGGL(hymba_fwd, dim3(grid), dim3(NWAVES * 64), LDS_BYTES, stream, a); }
}
```

```cpp
#include <hip/hip_runtime.h>
#include <cstdio>
#include <cstdint>


#ifndef MK_N_LAUNCHES
#define MK_N_LAUNCHES 1
#endif

namespace pg8 {
#define PG8_LAS __attribute__((address_space(3)))
typedef unsigned short bf16_t;
typedef short bf16x8 __attribute__((ext_vector_type(8)));
typedef float f32x4 __attribute__((ext_vector_type(4)));
typedef float f32x2 __attribute__((ext_vector_type(2)));
typedef unsigned u32x4 __attribute__((ext_vector_type(4)));
typedef unsigned u32x2 __attribute__((ext_vector_type(2)));
constexpr int BM = 256, BK = 64, HALF = 128, HTB = HALF * BK * 2, STAGE_BYTES = 8 * HTB, NXCD = 8, WGM = 8;

__host__ __device__ __forceinline__ int lds_byte(int r, int c) { const int st = (r >> 4) * 2 + (c >> 5), rr = r & 15, cc = c & 31, ob = rr * 64 + cc * 2; return st * 1024 + (ob ^ (((ob >> 9) & 1) << 5)); }
__host__ __device__ __forceinline__ void stage_rc(int b, int& R, int& C) { const int st = b / 1024, sb = b % 1024, swz = sb ^ (((sb >> 9) & 1) << 5); R = (st >> 1) * 16 + swz / 64; C = (st & 1) * 32 + (swz % 64) / 2; }
__host__ __device__ __forceinline__ int perm32(int rho) { const int n = rho >> 4, i = rho & 15; return 8 * (i >> 2) + 4 * n + (i & 3); }

struct Unit { int pm, pn; };
struct Gemm { const bf16_t* A; const bf16_t* Bt; int M, N, K; };

struct StaticOrder {
    int nM, nN, nwg, G, c;
    __host__ __device__ void init(int M, int N, int G_, int c_) { nM = M / BM; nN = N / BM; nwg = nM * nN; G = G_; c = c_; }
    __host__ __device__ bool next(int i, Unit& u) const {
        const long L = (long)i * G + c; if (L >= nwg) return false;
        int wgid = (int)L; { const int q = nwg / NXCD, r = nwg % NXCD, xcd = wgid % NXCD, off = wgid / NXCD; wgid = (xcd < r ? xcd * (q + 1) : r * (q + 1) + (xcd - r) * q) + off; }
        const int nig = WGM * nN, gid = wgid / nig, fm = gid * WGM, gsz = (nM - fm) < WGM ? (nM - fm) : WGM;
        u.pm = fm + ((wgid % nig) % gsz); u.pn = (wgid % nig) / gsz; return true;
    }
    __device__ __forceinline__ void a_ready(const Unit&) const {}
    __device__ __forceinline__ void done(const Unit&) const {}
};

typedef __bf16 bf16v2_t __attribute__((ext_vector_type(2)));
__device__ __forceinline__ unsigned cvt_pk_bf16(float lo, float hi) { const f32x2 v = {lo, hi}; return __builtin_bit_cast(unsigned, __builtin_convertvector(v, bf16v2_t)); }

template <class Epi, class Sched, bool ALIGN_EPI = false, bool SP2 = false>
__device__ __forceinline__ void gemm_phase(PG8_LAS unsigned char* lds, const Gemm g, const Sched& S, const Epi& E) {
    const int tid = threadIdx.x, wid = __builtin_amdgcn_readfirstlane(tid >> 6), lane = tid & 63, wr = wid >> 2, wc = wid & 3, fr = lane & 15, fq = lane >> 4;
    const int K = g.K, nt = K / BK;
    unsigned voffA[2], voffB[2];
#pragma unroll
    for (int i = 0; i < 2; ++i) { int R, C; stage_rc(tid * 16 + i * 8192, R, C); const int Rb = Epi::PERM ? ((R & ~31) + perm32(R & 31)) : R;
        voffA[i] = (unsigned)(R * K + C) * 2u; voffB[i] = (unsigned)(Rb * K + C) * 2u; }
    const size_t kstep = (size_t)(BK * 2);
    const size_t hstep = (size_t)HALF * K * 2;
    const size_t tstep = 2 * hstep;
    const unsigned ldsw = (unsigned)wid * 1024u;
    const int aoff = lds_byte(wr * 64 + fr, fq * 8), boff = lds_byte(wc * 32 + fr, fq * 8);
#define PG8_SA(b, h) (((b) * 2 + (h)) * HTB)
#define PG8_SB(b, h) ((4 + (b) * 2 + (h)) * HTB)
#define PG8_STAGE(bufoff, gbase, voff) do { _Pragma("unroll") for (int _i = 0; _i < 2; ++_i) \
        __builtin_amdgcn_global_load_lds((const unsigned*)((const char*)(gbase) + (voff)[_i]), (PG8_LAS unsigned*)(lds + (bufoff) + ldsw + _i * 8192), 16, 0, 0); } while (0)
#define PG8_LDA(dst, b, h) do { _Pragma("unroll") for (int m = 0; m < 4; ++m) _Pragma("unroll") for (int k = 0; k < 2; ++k) dst[m][k] = *(const PG8_LAS bf16x8*)(lds + PG8_SA(b, h) + aoff + m * 2048 + k * 1024); } while (0)
#define PG8_LDB(dst, b, h) do { _Pragma("unroll") for (int n = 0; n < 2; ++n) _Pragma("unroll") for (int k = 0; k < 2; ++k) dst[n][k] = *(const PG8_LAS bf16x8*)(lds + PG8_SB(b, h) + boff + n * 2048 + k * 1024); } while (0)
#define PG8_MMA(ai, bj, At, Bt) do { __builtin_amdgcn_s_setprio(1); _Pragma("unroll") for (int m = 0; m < 4; ++m) _Pragma("unroll") for (int n = 0; n < 2; ++n) _Pragma("unroll") for (int k = 0; k < 2; ++k) \
        acc[ai][bj][m][n] = __builtin_amdgcn_mfma_f32_16x16x32_bf16(Bt[n][k], At[m][k], acc[ai][bj][m][n], 0, 0, 0); __builtin_amdgcn_s_setprio(0); } while (0)
#define PG8_WAIT_V(n) asm volatile("s_waitcnt vmcnt(" #n ")" ::: "memory")
#define PG8_WAIT_L(n) asm volatile("s_waitcnt lgkmcnt(" #n ")" ::: "memory")
#define PG8_BAR __builtin_amdgcn_s_barrier()
#define PG8_SCHED __builtin_amdgcn_sched_barrier(0)
    Unit cur, nxt; int ui = 0;
    if (!S.next(0, cur)) return;
    f32x4 acc[2][2][4][2];
#pragma unroll
    for (int a = 0; a < 2; ++a)
#pragma unroll
        for (int b = 0; b < 2; ++b)
#pragma unroll
            for (int m = 0; m < 4; ++m)
#pragma unroll
                for (int n = 0; n < 2; ++n) acc[a][b][m][n] = (f32x4){0.f, 0.f, 0.f, 0.f};
    bf16x8 At[4][2], B0[2][2], B1[2][2];
    const char* cA = (const char*)g.A + (size_t)cur.pm * tstep; const char* cB = (const char*)g.Bt + (size_t)cur.pn * tstep;
    S.a_ready(cur);
    if constexpr (SP2) {
        PG8_STAGE(PG8_SB(0, 0), cB, voffB); PG8_STAGE(PG8_SB(0, 1), cB + hstep, voffB); PG8_STAGE(PG8_SA(0, 0), cA, voffA); PG8_STAGE(PG8_SA(0, 1), cA + hstep, voffA);
        if (wr == 1) PG8_BAR;
        PG8_WAIT_V(2); PG8_BAR;
        PG8_STAGE(PG8_SB(1, 0), cB + kstep, voffB); PG8_STAGE(PG8_SA(1, 0), cA + kstep, voffA); PG8_STAGE(PG8_SB(1, 1), cB + hstep + kstep, voffB);
        PG8_WAIT_V(6); PG8_BAR;
    } else {
        PG8_STAGE(PG8_SB(0, 0), cB, voffB); PG8_STAGE(PG8_SA(0, 0), cA, voffA); PG8_STAGE(PG8_SB(0, 1), cB + hstep, voffB); PG8_STAGE(PG8_SA(0, 1), cA + hstep, voffA);
        if (wr == 1) PG8_BAR;
        PG8_WAIT_V(4); PG8_BAR;
        PG8_STAGE(PG8_SB(1, 0), cB + kstep, voffB); PG8_STAGE(PG8_SA(1, 0), cA + kstep, voffA); PG8_STAGE(PG8_SB(1, 1), cB + hstep + kstep, voffB);
        PG8_WAIT_V(6); PG8_BAR;
    }
    for (;;) {
        const bool has_next = S.next(ui + 1, nxt);
        const char* nA = has_next ? (const char*)g.A + (size_t)nxt.pm * tstep : cA; const char* nB = has_next ? (const char*)g.Bt + (size_t)nxt.pn * tstep : cB;
        for (int t = 0; t < nt; t += 2) {
            const bool last = (t == nt - 2);
            const char* a1 = cA + (size_t)(t + 1) * kstep;
            const char* a2 = last ? nA : cA + (size_t)(t + 2) * kstep; const char* b2 = last ? nB : cB + (size_t)(t + 2) * kstep;
            const char* a3 = a2 + kstep; const char* b3 = b2 + kstep;
            if (last && has_next) S.a_ready(nxt);
            if constexpr (Epi::PREFETCH) { if (last) E.prefetch(cur, wid, lane); }
            if constexpr (SP2) {
            PG8_LDB(B0, 0, 0); PG8_LDB(B1, 0, 1); PG8_SCHED; PG8_LDA(At, 0, 0); PG8_STAGE(PG8_SA(1, 1), a1 + hstep, voffA);
            PG8_WAIT_V(8); PG8_WAIT_L(0); PG8_BAR; PG8_MMA(0, 0, At, B0); PG8_MMA(0, 1, At, B1); PG8_BAR; PG8_SCHED;
            PG8_LDA(At, 0, 1); PG8_STAGE(PG8_SB(0, 0), b2, voffB); PG8_STAGE(PG8_SB(0, 1), b2 + hstep, voffB); PG8_STAGE(PG8_SA(0, 0), a2, voffA);
            PG8_WAIT_V(8); PG8_WAIT_L(0); PG8_BAR; PG8_MMA(1, 0, At, B0); PG8_MMA(1, 1, At, B1); PG8_BAR; PG8_SCHED;
            PG8_LDB(B0, 1, 0); PG8_LDB(B1, 1, 1); PG8_SCHED; PG8_LDA(At, 1, 0); PG8_STAGE(PG8_SA(0, 1), a2 + hstep, voffA);
            PG8_WAIT_V(8); PG8_WAIT_L(0); PG8_BAR; PG8_MMA(0, 0, At, B0); PG8_MMA(0, 1, At, B1); PG8_BAR; PG8_SCHED;
            PG8_LDA(At, 1, 1); PG8_STAGE(PG8_SB(1, 0), b3, voffB); PG8_STAGE(PG8_SB(1, 1), b3 + hstep, voffB); PG8_STAGE(PG8_SA(1, 0), a3, voffA);
            PG8_WAIT_V(8); PG8_WAIT_L(0); PG8_BAR; PG8_MMA(1, 0, At, B0); PG8_MMA(1, 1, At, B1); PG8_BAR; PG8_SCHED;
            } else {
            PG8_LDB(B0, 0, 0); PG8_SCHED; PG8_LDA(At, 0, 0); PG8_STAGE(PG8_SA(1, 1), a1 + hstep, voffA);
            PG8_WAIT_L(8); PG8_BAR; PG8_WAIT_L(0); PG8_MMA(0, 0, At, B0); PG8_BAR; PG8_SCHED;
            PG8_LDB(B1, 0, 1); PG8_STAGE(PG8_SB(0, 0), b2, voffB);
            PG8_BAR; PG8_WAIT_L(0); PG8_MMA(0, 1, At, B1); PG8_BAR;
            PG8_LDA(At, 0, 1); PG8_STAGE(PG8_SA(0, 0), a2, voffA);
            PG8_BAR; PG8_WAIT_L(0); PG8_MMA(1, 0, At, B0); PG8_BAR; PG8_SCHED;
            PG8_STAGE(PG8_SB(0, 1), b2 + hstep, voffB);
            PG8_WAIT_V(6); PG8_BAR; PG8_MMA(1, 1, At, B1); PG8_BAR;
            PG8_LDB(B0, 1, 0); PG8_SCHED; PG8_LDA(At, 1, 0); PG8_STAGE(PG8_SA(0, 1), a2 + hstep, voffA);
            PG8_WAIT_L(8); PG8_BAR; PG8_WAIT_L(0); PG8_MMA(0, 0, At, B0); PG8_BAR; PG8_SCHED;
            PG8_LDB(B1, 1, 1); PG8_STAGE(PG8_SB(1, 0), b3, voffB);
            PG8_BAR; PG8_WAIT_L(0); PG8_MMA(0, 1, At, B1); PG8_BAR;
            PG8_LDA(At, 1, 1); PG8_STAGE(PG8_SA(1, 0), a3, voffA);
            PG8_BAR; PG8_WAIT_L(0); PG8_MMA(1, 0, At, B0); PG8_BAR; PG8_SCHED;
            PG8_STAGE(PG8_SB(1, 1), b3 + hstep, voffB);
            PG8_WAIT_V(6); PG8_BAR; PG8_MMA(1, 1, At, B1); PG8_BAR;
            }
        }
        if constexpr (ALIGN_EPI) { if (wr == 0) PG8_BAR; }
        E(acc, cur, wr, wc, fr, fq); S.done(cur);
        if (!has_next) break;
#pragma unroll
        for (int a = 0; a < 2; ++a)
#pragma unroll
            for (int b = 0; b < 2; ++b)
#pragma unroll
                for (int m = 0; m < 4; ++m)
#pragma unroll
                    for (int n = 0; n < 2; ++n) acc[a][b][m][n] = (f32x4){0.f, 0.f, 0.f, 0.f};
        cur = nxt; cA = nA; cB = nB; ++ui;
        if constexpr (ALIGN_EPI) { if (wr == 1) PG8_BAR; }
    }
    PG8_WAIT_V(0);
    if constexpr (!ALIGN_EPI) { if (wr == 0) PG8_BAR; }
    PG8_BAR;
#undef PG8_SA
#undef PG8_SB
#undef PG8_STAGE
#undef PG8_LDA
#undef PG8_LDB
#undef PG8_MMA
#undef PG8_WAIT_V
#undef PG8_WAIT_L
#undef PG8_BAR
#undef PG8_SCHED
}
}

#ifndef PG8_SP2
#define PG8_SP2 true
#endif
#ifndef PG8_ALIGN
#define PG8_ALIGN true
#endif

constexpr int NWAVES = 8;
constexpr int NPHASE = 9;
constexpr int N_LAUNCHES = MK_N_LAUNCHES;
constexpr int BATCH = 4, SEQ = 8192, D = 1024, M = BATCH * SEQ, PLE = 256, FF = 2816;
constexpr int PROJW = 3592, NIN = 3584;
constexpr int NGU = 2 * FF;
constexpr size_t MiB0 = 1u << 20;
constexpr float ALPHA = 1.189207115002721f;
constexpr float LN_EPS = 1e-5f, RMS_EPS = 1e-6f;
constexpr size_t UO_Q = 0, UO_K = 32 * MiB0, UO_V = 64 * MiB0, UO_G = 96 * MiB0, UO_MQ = 128 * MiB0, UO_MK = 144 * MiB0, UO_MV = 160 * MiB0, UO_MO = 192 * MiB0;
constexpr int C_HQ = 0, C_HF = 512, C_HV = 1024, C_HG = 1536, C_MQ = 2048, C_MK = 2304, C_MV = 2560, C_MO = 3072;

constexpr size_t MiB = 1u << 20;
constexpr size_t WS_CTL = 0, CTL_ZERO_BYTES = 1 * MiB;
constexpr int CW_BAR = 4096;
constexpr size_t CTL_CS_GU = 64 * 1024, CTL_BW_GU = CTL_CS_GU + NGU * 4, CTL_CS_PG = CTL_BW_GU + NGU * 4, CTL_BW_PG = CTL_CS_PG + D * 4;
static_assert(CTL_BW_PG + D * 4 <= 128 * 1024, "ctl vectors");
constexpr size_t CTL_G1 = 128 * 1024, CTL_B1 = CTL_G1 + D * 4, CTL_G2 = CTL_B1 + D * 4, CTL_B2 = CTL_G2 + D * 4, CTL_BG = CTL_B2 + D * 4, CTL_BIAS = 160 * 1024;
constexpr size_t CTL_ST1 = 256 * 1024, CTL_ST2 = 512 * 1024;
static_assert(CTL_ST2 + (size_t)M * 8 <= CTL_ZERO_BYTES, "ctl stats");
constexpr size_t WS_OML = 1 * MiB;
constexpr size_t WS_WIN = 2 * MiB;
constexpr size_t WS_WOUT = 9 * MiB;
constexpr size_t WS_WGU = 11 * MiB;
constexpr size_t WS_WDN = 22 * MiB;
constexpr size_t WS_WPG = 28 * MiB;
constexpr size_t WS_WPP = 30 * MiB;
constexpr size_t WS_GATES = 31 * MiB;
constexpr size_t WS_XB = 32 * MiB;
constexpr size_t WS_PB = 96 * MiB;
constexpr size_t WS_U = 112 * MiB;
constexpr size_t WS_LOGF = 336 * MiB;
constexpr size_t WS_ER = 400 * MiB;
constexpr size_t WS_EL = 401 * MiB;
constexpr size_t WS_ASC = 402 * MiB;
constexpr size_t WS_MLS = 403 * MiB;
constexpr size_t WS_MLN = 404 * MiB;
constexpr size_t WS_HGS = 408 * MiB;
constexpr size_t WS_MLC = 440 * MiB;
constexpr size_t WS_HGI = 456 * MiB;
constexpr size_t WS_MLCI = 488 * MiB;
constexpr size_t WS_MLNI = 504 * MiB;
constexpr size_t WS_MLI = 505 * MiB;
constexpr size_t WS_END = 506 * MiB;

constexpr int RING_OFF = 0, RING_BYTES = 131072;
constexpr int LDS_BYTES = 163840;
constexpr int COLV_OFF = RING_OFF + RING_BYTES;
constexpr int LDSCTL_OFF = LDS_BYTES - 1024, MISC_OFF = LDSCTL_OFF + 320;

#define GAS __attribute__((address_space(1)))
#define LAS __attribute__((address_space(3)))
typedef unsigned short bf16;
typedef unsigned v4u __attribute__((ext_vector_type(4)));
typedef unsigned v2u __attribute__((ext_vector_type(2)));
typedef float f32x4 __attribute__((ext_vector_type(4)));
typedef float f32x2 __attribute__((ext_vector_type(2)));
typedef GAS unsigned gu32;
#define RLX_AGENT __ATOMIC_RELAXED, __HIP_MEMORY_SCOPE_AGENT
#define LDS_WAIT() asm volatile("s_waitcnt lgkmcnt(0)" ::: "memory")
#define VM_WAIT() asm volatile("s_waitcnt vmcnt(0)" ::: "memory")
__device__ __forceinline__ unsigned f2bf(float f) { unsigned u = __builtin_bit_cast(unsigned, f); return (u + 0x7fffu + ((u >> 16) & 1u)) >> 16; }
__device__ __forceinline__ unsigned pk2(float lo, float hi) { return f2bf(lo) | (f2bf(hi) << 16); }
__device__ __forceinline__ float bf2f(unsigned short b) { return __builtin_bit_cast(float, (unsigned)b << 16); }
__device__ __forceinline__ float bflo(unsigned w) { return __builtin_bit_cast(float, w << 16); }
__device__ __forceinline__ float bfhi(unsigned w) { return __builtin_bit_cast(float, w & 0xffff0000u); }
__device__ __forceinline__ float fsigmoid(float x) { return __builtin_amdgcn_rcpf(1.0f + __expf(-x)); }
__device__ __forceinline__ float fsilu(float x) { return x * fsigmoid(x); }
__device__ __forceinline__ float wave_sum(float v) {
#pragma unroll
    for (int o = 1; o < 64; o <<= 1) v += __shfl_xor(v, o);
    return v;
}

#define XB_TMO      128
#define XB_XCNT(j)  (256  + 64 * (j))
#define XB_XSUB(j)  (1280 + 64 * (j))
#define XB_XGEN(j)  (2304 + 64 * (j))
#define XB_TOP      3328
#define XB_TOPGEN   3392
#define XCD_BAR_WORDS 3456
#define XB_SPIN_CAP (1u << 22)
__device__ __forceinline__ unsigned xb_ld(unsigned* p)              { return __hip_atomic_load(p, __ATOMIC_RELAXED, __HIP_MEMORY_SCOPE_AGENT); }
__device__ __forceinline__ unsigned xb_add(unsigned* p, unsigned v) { return __hip_atomic_fetch_add(p, v, __ATOMIC_RELAXED, __HIP_MEMORY_SCOPE_AGENT); }
__device__ __forceinline__ unsigned xb_xcc_id() { return (unsigned)__builtin_amdgcn_s_getreg((3 << 11) | 20) & 0xFu; }
#define XB_SPIN(cond, bar) do { unsigned _sp = 0; while (cond) { __builtin_amdgcn_s_sleep(1); \
    if ((++_sp & 255u) == 0u) { if (xb_ld(&(bar)[XB_TMO])) break; if (_sp > XB_SPIN_CAP) { atomicAdd(&(bar)[XB_TMO], 1u); break; } } } } while (0)
struct XcdBarrier { unsigned* bar; unsigned x; volatile LAS unsigned* st; };
__device__ __forceinline__ XcdBarrier xcd_barrier_post(unsigned* bar, volatile LAS unsigned* st) {
    XcdBarrier b; b.bar = bar; b.x = xb_xcc_id(); b.st = st;
    if (threadIdx.x == 0) (void)xb_add(&bar[XB_XCNT(b.x)], 1u);
    return b;
}
__device__ __forceinline__ void xcd_barrier_complete(unsigned* bar, unsigned x, unsigned& nloc, unsigned& nx) {
    const unsigned G = gridDim.x * gridDim.y * gridDim.z;
    unsigned sum, cnt, mine, sp = 0u;
    for (;;) {
        sum = 0u; cnt = 0u; mine = 0u;
#pragma unroll
        for (unsigned j = 0; j < 16; ++j) { const unsigned c = xb_ld(&bar[XB_XCNT(j)]); sum += c; cnt += (c > 0u) ? 1u : 0u; mine = (j == x) ? c : mine; }
        if (sum == G) break;
        __builtin_amdgcn_s_sleep(1);
        if ((++sp & 255u) == 0u) { if (xb_ld(&bar[XB_TMO])) break; if (sp > XB_SPIN_CAP) { atomicAdd(&bar[XB_TMO], 1u); break; } }
    }
    nloc = mine > 0u ? mine : 1u; nx = cnt > 0u ? cnt : 1u;
}
__device__ __forceinline__ void xcd_barrier(const XcdBarrier& b) {
    asm volatile("s_waitcnt vmcnt(0)" ::: "memory");
    __syncthreads();
    if (threadIdx.x == 0) {
        unsigned* bar = b.bar;
        __builtin_amdgcn_s_waitcnt(0);
        unsigned nloc = b.st[0], nx = b.st[1];
        if (nloc == 0u) { xcd_barrier_complete(bar, b.x, nloc, nx); b.st[0] = nloc; b.st[1] = nx; }
        const unsigned old = xb_add(&bar[XB_XSUB(b.x)], 1u);
        const unsigned gen = old / nloc;
        if (old + 1u == (gen + 1u) * nloc) {
            __builtin_amdgcn_fence(__ATOMIC_RELEASE, "agent");
            asm volatile("s_waitcnt vmcnt(0)" ::: "memory");
            const unsigned og = xb_add(&bar[XB_TOP], 1u);
            const unsigned tg = og / nx;
            if (og + 1u == (tg + 1u) * nx) xb_add(&bar[XB_TOPGEN], 1u);
            else XB_SPIN(xb_ld(&bar[XB_TOPGEN]) == tg, bar);
            __builtin_amdgcn_fence(__ATOMIC_ACQUIRE, "agent");
            xb_add(&bar[XB_XGEN(b.x)], 1u);
            asm volatile("s_waitcnt vmcnt(0)" ::: "memory");
        } else {
            XB_SPIN(xb_ld(&bar[XB_XGEN(b.x)]) == gen, bar);
            __builtin_amdgcn_fence(__ATOMIC_ACQUIRE, "agent");
            asm volatile("s_waitcnt vmcnt(0)" ::: "memory");
        }
    }
    __syncthreads();
}

using pg8::Unit; using pg8::cvt_pk_bf16; using pg8::HALF; using pg8::BM;
#define HF_DPP(x, ctrl) __builtin_bit_cast(float, __builtin_amdgcn_update_dpp(0, __builtin_bit_cast(int, (x)), (ctrl), 0xF, 0xF, true))
struct EpiInProj {
    static constexpr bool PERM = true, PREFETCH = true;
    unsigned char* ws; LAS unsigned char* pre;
    __device__ __forceinline__ void prefetch(const Unit& u, int wid, int lane) const {
        if (wid < 2) { const int pn = u.pn; const float* src; const float* bias = (const float*)(ws + WS_CTL + CTL_BIAS); const float* oml = (const float*)(ws + WS_OML);
            if (wid == 0) src = (pn < 4) ? bias + ((lane < 32) ? (C_HQ + 128 * pn + 4 * lane) : (C_HF + 128 * pn + 4 * (lane - 32))) : bias + 256 * pn + 4 * lane;
            else src = oml + 128 * (pn & 3) + 4 * (lane & 31);
            __builtin_amdgcn_global_load_lds((const unsigned*)src, (LAS unsigned*)(pre + wid * 1024), 16, 0, 0); }
    }
    __device__ __forceinline__ void operator()(const f32x4 (&acc)[2][2][4][2], const Unit& u, int wr, int wc, int fr, int fq) const {
        const int row0 = u.pm * BM + wr * 64 + fr, col0 = u.pn * BM + wc * 32 + 8 * fq;
        const int pn = u.pn; bf16* U = (bf16*)(ws + WS_U);
        const int type = (pn < 4) ? 3 : (pn < 6) ? 0 : (pn < 8) ? 1 : (pn < 12) ? 0 : 2;
        if (type != 3) {
            f32x4 bv[2][2];
#pragma unroll
            for (int bj = 0; bj < 2; ++bj)
#pragma unroll
                for (int n = 0; n < 2; ++n) bv[bj][n] = *(const LAS f32x4*)((const LAS float*)pre + wc * 32 + 8 * fq + bj * HALF + 4 * n);
            const size_t tbase = (pn < 6) ? UO_V : (pn < 8) ? UO_G : (pn == 8) ? UO_MQ : (pn == 9) ? UO_MK : (pn < 12) ? UO_MV : UO_MO;
            const bool narrow = (pn == 8) || (pn == 9);
            const int hpair = narrow ? 0 : 2 * (pn & 1);
            bf16* dst[2];
#pragma unroll
            for (int bj = 0; bj < 2; ++bj) { const int head = narrow ? (2 * bj + (wc >> 1)) : (hpair + bj); const int colh = narrow ? ((wc & 1) * 32 + 8 * fq) : (wc * 32 + 8 * fq);
                dst[bj] = (bf16*)((char*)U + tbase) + (size_t)head * M * (narrow ? 64 : 128) + colh; }
            const int W = narrow ? 64 : 128;
#pragma unroll
            for (int ai = 0; ai < 2; ++ai)
#pragma unroll
                for (int m = 0; m < 4; ++m) { const size_t row = (size_t)(row0 + ai * HALF + m * 16);
#pragma unroll
                    for (int bj = 0; bj < 2; ++bj) { f32x4 v0 = acc[ai][bj][m][0] + bv[bj][0], v1 = acc[ai][bj][m][1] + bv[bj][1];
                        if (type == 1) {
#pragma unroll
                            for (int j = 0; j < 4; ++j) { v0[j] = fsilu(v0[j]); v1[j] = fsilu(v1[j]); }
                        } else if (type == 2) {
#pragma unroll
                            for (int j = 0; j < 4; ++j) { v0[j] = fsigmoid(v0[j]); v1[j] = fsigmoid(v1[j]); }
                        }
                        pg8::u32x4 w; w.x = cvt_pk_bf16(v0[0], v0[1]); w.y = cvt_pk_bf16(v0[2], v0[3]); w.z = cvt_pk_bf16(v1[0], v1[1]); w.w = cvt_pk_bf16(v1[2], v1[3]);
                        *(pg8::u32x4*)(dst[bj] + row * W) = w; } }
        } else {
            const int ch = wc * 32 + 8 * fq;
            f32x4 bvv[2], ovv[2], bqv[2];
#pragma unroll
            for (int n = 0; n < 2; ++n) { const LAS float* P = (const LAS float*)pre + ch + 4 * n; bqv[n] = *(const LAS f32x4*)P; bvv[n] = *(const LAS f32x4*)(P + 128); ovv[n] = *(const LAS f32x4*)(P + 256); }
#pragma unroll
            for (int ai = 0; ai < 2; ++ai) { const int cidx = u.pm * 4 + ai * 2 + wr;
#pragma unroll
                for (int n = 0; n < 2; ++n) { const size_t hoff = ((size_t)pn * M + (size_t)(row0 + ai * HALF)) * 128 + ch + 4 * n;
                    hf_block(acc[ai][1][0][n], acc[ai][1][1][n], acc[ai][1][2][n], acc[ai][1][3][n], acc[ai][0][0][n], acc[ai][0][1][n], acc[ai][0][2][n], acc[ai][0][3][n],
                             bvv[n], ovv[n], bqv[n], pn * 128 + ch + 4 * n, (bf16*)((char*)U + UO_Q) + hoff, (bf16*)((char*)U + UO_K) + hoff, cidx, fr); } }
        }
    }
    static __device__ __forceinline__ float hf_total(float scanv) {
        float o = scanv - HF_DPP(scanv, 0x111);
        o += HF_DPP(o, 0x128); o += HF_DPP(o, 0x124); o += HF_DPP(o, 0x122); o += HF_DPP(o, 0x121); return o; }
    __device__ __forceinline__ void hf_block(const f32x4& a0, const f32x4& a1, const f32x4& a2, const f32x4& a3, const f32x4& q0, const f32x4& q1, const f32x4& q2, const f32x4& q3, const f32x4& bv, const f32x4& ov, const f32x4& bq, int c, bf16* uqp, bf16* ukp, int cidx, int fr) const {
        f32x4 k0, k1, k2, k3, l0, l1, l2, l3;
#define HF_SCAN { x += HF_DPP(x, 0x111); x += HF_DPP(x, 0x112); x += HF_DPP(x, 0x114); x += HF_DPP(x, 0x118); }
#define HF_BC(v) hf_total(v)
#define HF_ONE(A, KK, LL) _Pragma("unroll") for (int j = 0; j < 4; ++j) { const float k = ov[j] * fsigmoid(-(A[j] + bv[j])); KK[j] = k; float x = __logf(1.0f - k); \
            HF_SCAN LL[j] = x; }
        HF_ONE(a0, k0, l0) __builtin_amdgcn_sched_barrier(0); HF_ONE(a1, k1, l1) __builtin_amdgcn_sched_barrier(0); HF_ONE(a2, k2, l2) __builtin_amdgcn_sched_barrier(0); HF_ONE(a3, k3, l3) __builtin_amdgcn_sched_barrier(0);
#undef HF_ONE
        f32x4 t0, t1, t2, t3;
#pragma unroll
        for (int j = 0; j < 4; ++j) { t0[j] = HF_BC(l0[j]); t1[j] = HF_BC(l1[j]); t2[j] = HF_BC(l2[j]); t3[j] = HF_BC(l3[j]); }
        const f32x4 r = t0 + t1, bl = r + t2 + t3;
        const f32x4 b0 = l0, b1 = l1 + t0, b2 = l2 + r, b3 = l3 + r + t2;
#define HF_ST(B, KK, QQ, M) { f32x4 e, kt; _Pragma("unroll") for (int j = 0; j < 4; ++j) { e[j] = fsilu(QQ[j] + bq[j]) * __expf(B[j] - r[j]); kt[j] = KK[j] * __expf(r[j] - B[j]); } \
            pg8::u32x2 we, wk; we.x = cvt_pk_bf16(e[0], e[1]); we.y = cvt_pk_bf16(e[2], e[3]); wk.x = cvt_pk_bf16(kt[0], kt[1]); wk.y = cvt_pk_bf16(kt[2], kt[3]); \
            *(pg8::u32x2*)(uqp + (size_t)(M) * 16 * 128) = we; *(pg8::u32x2*)(ukp + (size_t)(M) * 16 * 128) = wk; }
        HF_ST(b0, k0, q0, 0) __builtin_amdgcn_sched_barrier(0); HF_ST(b1, k1, q1, 1) __builtin_amdgcn_sched_barrier(0); HF_ST(b2, k2, q2, 2) __builtin_amdgcn_sched_barrier(0); HF_ST(b3, k3, q3, 3) __builtin_amdgcn_sched_barrier(0);
#undef HF_ST
        if (fr == 0) { f32x4 er, el; float* ER = (float*)(ws + WS_ER); float* EL = (float*)(ws + WS_EL);
#pragma unroll
            for (int j = 0; j < 4; ++j) { er[j] = __expf(r[j]); el[j] = __expf(bl[j] - r[j]); }
            *(f32x4*)(ER + (size_t)cidx * 512 + c) = er; *(f32x4*)(EL + (size_t)cidx * 512 + c) = el; }
    }
};
struct EpiOutProj {
    static constexpr bool PERM = true, PREFETCH = false;
    unsigned char* ws; unsigned stoff;
    __device__ __forceinline__ void operator()(const f32x4 (&acc)[2][2][4][2], const Unit& u, int wr, int wc, int fr, int fq) const {
        const int row0 = u.pm * BM + wr * 64 + fr, col0 = u.pn * BM + wc * 32 + 8 * fq;
        const bf16* X = (const bf16*)(ws + WS_XB); bf16* YB = (bf16*)(ws + WS_LOGF); float* ST = (float*)(ws + WS_CTL + stoff);
        pg8::u32x4 xw[4][2];
#pragma unroll
        for (int m = 0; m < 4; ++m)
#pragma unroll
            for (int bj = 0; bj < 2; ++bj) xw[m][bj] = __builtin_nontemporal_load((const pg8::u32x4*)(X + (size_t)(row0 + m * 16) * D + col0 + bj * HALF));
#pragma unroll
        for (int ai = 0; ai < 2; ++ai) {
#pragma unroll
            for (int m = 0; m < 4; ++m) { const size_t row = (size_t)(row0 + ai * HALF + m * 16); const size_t off = row * D + col0; float s = 0.f, q = 0.f;
                const pg8::u32x4 xc[2] = {xw[m][0], xw[m][1]};
                if (ai == 0) {
#pragma unroll
                    for (int bj = 0; bj < 2; ++bj) xw[m][bj] = __builtin_nontemporal_load((const pg8::u32x4*)(X + (size_t)(row0 + HALF + m * 16) * D + col0 + bj * HALF)); }
#pragma unroll
                for (int bj = 0; bj < 2; ++bj) { const pg8::u32x4 x = xc[bj];
                    const f32x4 x0 = {bflo(x.x), bfhi(x.x), bflo(x.y), bfhi(x.y)}, x1 = {bflo(x.z), bfhi(x.z), bflo(x.w), bfhi(x.w)};
                    const f32x4 v0 = x0 * ALPHA + acc[ai][bj][m][0], v1 = x1 * ALPHA + acc[ai][bj][m][1];
                    pg8::u32x4 w; w.x = cvt_pk_bf16(v0[0], v0[1]); w.y = cvt_pk_bf16(v0[2], v0[3]); w.z = cvt_pk_bf16(v1[0], v1[1]); w.w = cvt_pk_bf16(v1[2], v1[3]);
                    *(pg8::u32x4*)(YB + off + bj * HALF) = w;
                    s += (v0[0] + v0[1]) + (v0[2] + v0[3]) + (v1[0] + v1[1]) + (v1[2] + v1[3]);
                    q += (v0[0] * v0[0] + v0[1] * v0[1]) + (v0[2] * v0[2] + v0[3] * v0[3]) + (v1[0] * v1[0] + v1[1] * v1[1]) + (v1[2] * v1[2] + v1[3] * v1[3]); }
                s += __shfl_xor(s, 16); s += __shfl_xor(s, 32); q += __shfl_xor(q, 16); q += __shfl_xor(q, 32);
                if (fq == 0) { atomicAdd(ST + 2 * row, s); atomicAdd(ST + 2 * row + 1, q); }
                asm volatile("" ::: "memory"); } }
    }
};
struct EpiGateUp {
    static constexpr bool PERM = true, PREFETCH = true;
    unsigned char* ws; LAS unsigned char* pre;
    __device__ __forceinline__ void prefetch(const Unit& u, int wid, int lane) const {
        if (wid < 4) { const float* ST = (const float*)(ws + WS_CTL + CTL_ST1); const float* cs = (const float*)(ws + WS_CTL + CTL_CS_GU); const float* bw = (const float*)(ws + WS_CTL + CTL_BW_GU);
            const float* src = (wid < 2) ? ST + 2 * (size_t)(u.pm * BM + 128 * wid) + 4 * lane : ((wid == 2) ? cs : bw) + u.pn * BM + 4 * lane;
            __builtin_amdgcn_global_load_lds((const unsigned*)src, (LAS unsigned*)(pre + wid * 1024), 16, 0, 0); }
    }
    __device__ __forceinline__ void operator()(const f32x4 (&acc)[2][2][4][2], const Unit& u, int wr, int wc, int fr, int fq) const {
        const int rl = wr * 64 + fr, row0 = u.pm * BM + rl, cw = wc * 32 + 8 * fq;
        const LAS float* P = (const LAS float*)pre; bf16* H = (bf16*)(ws + WS_U);
        f32x4 cg[2], cu[2], bg[2], bu[2];
#pragma unroll
        for (int n = 0; n < 2; ++n) { cg[n] = *(const LAS f32x4*)(P + 512 + cw + 4 * n); cu[n] = *(const LAS f32x4*)(P + 512 + HALF + cw + 4 * n); bg[n] = *(const LAS f32x4*)(P + 768 + cw + 4 * n); bu[n] = *(const LAS f32x4*)(P + 768 + HALF + cw + 4 * n); }
        float mua[2][4], rra[2][4];
#pragma unroll
        for (int ai = 0; ai < 2; ++ai)
#pragma unroll
            for (int m = 0; m < 4; ++m) { const f32x2 st = *(const LAS f32x2*)(P + 2 * (rl + ai * HALF + m * 16));
                const float mean = st.x * (1.0f / D), var = st.y * (1.0f / D) - mean * mean; mua[ai][m] = mean; rra[ai][m] = __builtin_amdgcn_rsqf(fmaxf(var, 0.f) + LN_EPS); }
#pragma unroll
        for (int ai = 0; ai < 2; ++ai)
#pragma unroll
            for (int m = 0; m < 4; ++m) { const size_t row = (size_t)(row0 + ai * HALF + m * 16);
                const float mu = mua[ai][m], r = rra[ai][m];
                f32x4 hv[2];
#pragma unroll
                for (int n = 0; n < 2; ++n) {
#pragma unroll
                    for (int j = 0; j < 4; ++j) { const float g = r * (acc[ai][0][m][n][j] - mu * cg[n][j]) + bg[n][j]; const float up = r * (acc[ai][1][m][n][j] - mu * cu[n][j]) + bu[n][j]; hv[n][j] = fsilu(g) * up; } }
                pg8::u32x4 w; w.x = cvt_pk_bf16(hv[0][0], hv[0][1]); w.y = cvt_pk_bf16(hv[0][2], hv[0][3]); w.z = cvt_pk_bf16(hv[1][0], hv[1][1]); w.w = cvt_pk_bf16(hv[1][2], hv[1][3]);
                *(pg8::u32x4*)(H + row * FF + u.pn * HALF + cw) = w; }
    }
};
struct EpiDown {
    static constexpr bool PERM = true, PREFETCH = true;
    unsigned char* ws; LAS unsigned char* pre;
    __device__ __forceinline__ void prefetch(const Unit& u, int wid, int lane) const {
        if (wid < 4) { const float* ST1 = (const float*)(ws + WS_CTL + CTL_ST1); const float* g1 = (const float*)(ws + WS_CTL + CTL_G1); const float* b1 = (const float*)(ws + WS_CTL + CTL_B1);
            const float* src = (wid < 2) ? ST1 + 2 * (size_t)(u.pm * BM + 128 * wid) + 4 * lane : ((wid == 2) ? g1 : b1) + u.pn * BM + 4 * lane;
            __builtin_amdgcn_global_load_lds((const unsigned*)src, (LAS unsigned*)(pre + wid * 1024), 16, 0, 0); }
    }
    __device__ __forceinline__ void operator()(const f32x4 (&acc)[2][2][4][2], const Unit& u, int wr, int wc, int fr, int fq) const {
        const int row0 = u.pm * BM + wr * 64 + fr, col0 = u.pn * BM + wc * 32 + 8 * fq;
        bf16* YB = (bf16*)(ws + WS_LOGF); float* ST2 = (float*)(ws + WS_CTL + CTL_ST2);
        f32x4 gv[2][2], bv[2][2];
#pragma unroll
        for (int bj = 0; bj < 2; ++bj)
#pragma unroll
            for (int n = 0; n < 2; ++n) { const LAS float* P = (const LAS float*)pre + 512 + wc * 32 + 8 * fq + bj * HALF + 4 * n; gv[bj][n] = *(const LAS f32x4*)P; bv[bj][n] = *(const LAS f32x4*)(P + 256); }
        pg8::u32x4 yw[3][2];
#pragma unroll
        for (int m = 0; m < 3; ++m)
#pragma unroll
            for (int bj = 0; bj < 2; ++bj) yw[m][bj] = *(const pg8::u32x4*)(YB + (size_t)(row0 + m * 16) * D + col0 + bj * HALF);
#pragma unroll
        for (int ai = 0; ai < 2; ++ai) {
#pragma unroll
            for (int m = 0; m < 4; ++m) { const size_t row = (size_t)(row0 + ai * HALF + m * 16); const size_t off = row * D + col0; float s = 0.f, q = 0.f; const int ri = ai * 4 + m, sl = ri % 3;
                const f32x2 st = *(const LAS f32x2*)((const LAS float*)pre + 2 * (wr * 64 + fr + ai * HALF + m * 16));
                const float mu = st.x * (1.0f / D), var = st.y * (1.0f / D) - mu * mu, r = __builtin_amdgcn_rsqf(fmaxf(var, 0.f) + LN_EPS);
                const pg8::u32x4 yc[2] = {yw[sl][0], yw[sl][1]};
                if (ri + 3 < 8) { const int na = (ri + 3) >> 2, nm = (ri + 3) & 3;
#pragma unroll
                    for (int bj = 0; bj < 2; ++bj) yw[sl][bj] = *(const pg8::u32x4*)(YB + (size_t)(row0 + na * HALF + nm * 16) * D + col0 + bj * HALF); }
#pragma unroll
                for (int bj = 0; bj < 2; ++bj) { const pg8::u32x4 y = yc[bj];
                    const f32x4 y0 = {bflo(y.x), bfhi(y.x), bflo(y.y), bfhi(y.y)}, y1 = {bflo(y.z), bfhi(y.z), bflo(y.w), bfhi(y.w)};
                    const f32x4 x0 = (y0 - mu) * r * gv[bj][0] + bv[bj][0], x1 = (y1 - mu) * r * gv[bj][1] + bv[bj][1];
                    const f32x4 v0 = x0 * ALPHA + acc[ai][bj][m][0], v1 = x1 * ALPHA + acc[ai][bj][m][1];
                    pg8::u32x4 w; w.x = cvt_pk_bf16(v0[0], v0[1]); w.y = cvt_pk_bf16(v0[2], v0[3]); w.z = cvt_pk_bf16(v1[0], v1[1]); w.w = cvt_pk_bf16(v1[2], v1[3]);
                    *(pg8::u32x4*)(YB + off + bj * HALF) = w;
                    s += (v0[0] + v0[1]) + (v0[2] + v0[3]) + (v1[0] + v1[1]) + (v1[2] + v1[3]);
                    q += (v0[0] * v0[0] + v0[1] * v0[1]) + (v0[2] * v0[2] + v0[3] * v0[3]) + (v1[0] * v1[0] + v1[1] * v1[1]) + (v1[2] * v1[2] + v1[3] * v1[3]); }
                s += __shfl_xor(s, 16); s += __shfl_xor(s, 32); q += __shfl_xor(q, 16); q += __shfl_xor(q, 32);
                if (fq == 0) { atomicAdd(ST2 + 2 * row, s); atomicAdd(ST2 + 2 * row + 1, q); }
                asm volatile("" ::: "memory"); } }
    }
};
struct EpiPleP {
    static constexpr bool PERM = true, PREFETCH = false;
    unsigned char* ws;
    __device__ __forceinline__ void operator()(const f32x4 (&acc)[2][2][4][2], const Unit& u, int wr, int wc, int fr, int fq) const {
        pg8::u32x4* slab = (pg8::u32x4*)(ws + WS_XB) + (size_t)(u.pm * 4 + u.pn) * 8192 + threadIdx.x;
#pragma unroll
        for (int ai = 0; ai < 2; ++ai)
#pragma unroll
            for (int m = 0; m < 4; ++m)
#pragma unroll
                for (int bj = 0; bj < 2; ++bj) { const f32x4 v0 = acc[ai][bj][m][0], v1 = acc[ai][bj][m][1];
                    pg8::u32x4 w; w.x = cvt_pk_bf16(v0[0], v0[1]); w.y = cvt_pk_bf16(v0[2], v0[3]); w.z = cvt_pk_bf16(v1[0], v1[1]); w.w = cvt_pk_bf16(v1[2], v1[3]);
                    slab[((ai * 4 + m) * 2 + bj) * 512] = w; }
    }
};
struct EpiFinal {
    static constexpr bool PERM = true, PREFETCH = true;
    float* OUT; unsigned char* ws; LAS unsigned char* pre;
    __device__ __forceinline__ void prefetch(const Unit& u, int wid, int lane) const {
        if (wid < 7) { const size_t vo = (wid == 2) ? CTL_G2 : (wid == 3) ? CTL_B2 : (wid == 4) ? CTL_CS_PG : (wid == 5) ? CTL_BW_PG : CTL_BG;
            const float* src = (wid < 2) ? (const float*)(ws + WS_CTL + CTL_ST2) + 2 * (size_t)(u.pm * BM + 128 * wid) + 4 * lane : (const float*)(ws + WS_CTL + vo) + u.pn * BM + 4 * lane;
            __builtin_amdgcn_global_load_lds((const unsigned*)src, (LAS unsigned*)(pre + wid * 1024), 16, 0, 0); }
    }
    __device__ __forceinline__ void operator()(const f32x4 (&acc)[2][2][4][2], const Unit& u, int wr, int wc, int fr, int fq) const {
        const int row0 = u.pm * BM + wr * 64 + fr, col0 = u.pn * BM + wc * 32 + 8 * fq;
        const bf16* YB = (const bf16*)(ws + WS_LOGF);
        const pg8::u32x4* slab = (const pg8::u32x4*)(ws + WS_XB) + (size_t)(u.pm * 4 + u.pn) * 8192 + threadIdx.x;
        float mu[2][4], rr[2][4];
#pragma unroll
        for (int ai = 0; ai < 2; ++ai)
#pragma unroll
            for (int m = 0; m < 4; ++m) { const size_t row = (size_t)(row0 + ai * HALF + m * 16);
                const f32x2 st = *(const LAS f32x2*)((const LAS float*)pre + 2 * (wr * 64 + fr + ai * HALF + m * 16)); const float mean = st.x * (1.0f / D), var = st.y * (1.0f / D) - mean * mean; mu[ai][m] = mean; rr[ai][m] = __builtin_amdgcn_rsqf(fmaxf(var, 0.f) + LN_EPS); }
#pragma unroll
        for (int bj = 0; bj < 2; ++bj) { const int c = col0 + bj * HALF;
            f32x4 gv[2], bv[2], cv[2], wv[2];
#pragma unroll
            for (int n = 0; n < 2; ++n) { const LAS float* P = (const LAS float*)pre + 512 + wc * 32 + 8 * fq + bj * HALF + 4 * n;
                gv[n] = *(const LAS f32x4*)P; bv[n] = *(const LAS f32x4*)(P + 256); cv[n] = *(const LAS f32x4*)(P + 512); wv[n] = *(const LAS f32x4*)(P + 768) + *(const LAS f32x4*)(P + 1024); }
#pragma unroll
            for (int ai = 0; ai < 2; ++ai) {
#pragma unroll
                for (int m = 0; m < 4; ++m) { const size_t off = (size_t)(row0 + ai * HALF + m * 16) * D + c;
                    const pg8::u32x4 yw = *(const pg8::u32x4*)(YB + off), pw = __builtin_nontemporal_load(slab + ((ai * 4 + m) * 2 + bj) * 512);
                    const f32x4 y[2] = {{bflo(yw.x), bfhi(yw.x), bflo(yw.y), bfhi(yw.y)}, {bflo(yw.z), bfhi(yw.z), bflo(yw.w), bfhi(yw.w)}};
                    const f32x4 pp[2] = {{bflo(pw.x), bfhi(pw.x), bflo(pw.y), bfhi(pw.y)}, {bflo(pw.z), bfhi(pw.z), bflo(pw.w), bfhi(pw.w)}};
                    const float mean = mu[ai][m], r = rr[ai][m];
#pragma unroll
                    for (int n = 0; n < 2; ++n) { const f32x4 x2 = (y[n] - mean) * r * gv[n] + bv[n]; f32x4 o;
#pragma unroll
                        for (int j = 0; j < 4; ++j) { const float gp = r * (acc[ai][bj][m][n][j] - mean * cv[n][j]) + wv[n][j]; o[j] = x2[j] + fsigmoid(gp) * pp[n][j]; }
                        __builtin_nontemporal_store(o, (f32x4*)(OUT + off + 4 * n)); } }
                asm volatile("" ::: "memory"); } }
    }
};

struct Frame {
    LAS unsigned char* lds;
    int tid, lane, wave, vcu, G;
};

template <int MAP>
__device__ __forceinline__ void p0_transpose_item(const float* W, int K, int ldw, int nblk, bf16* WT, const float* gk, const float* bk, float* cs, float* bw, LAS float* scr, int item, int lane) {
    const int kb = item / nblk, nb = item % nblk, k0 = 64 * kb, n0 = 32 * nb;
#pragma unroll 8
    for (int i = 0; i < 32; ++i) { const int kk = 2 * i + (lane >> 5); scr[kk * 33 + (lane & 31)] = __builtin_nontemporal_load(W + (size_t)(k0 + kk) * ldw + n0 + (lane & 31)); }
    LDS_WAIT(); asm volatile("" ::: "memory");
    const int c = lane & 7;
    float gs[8], bs[8];
#pragma unroll
    for (int e = 0; e < 8; ++e) { gs[e] = gk ? gk[k0 + 8 * c + e] : 1.0f; bs[e] = bk ? bk[k0 + 8 * c + e] : 0.0f; }
#pragma unroll
    for (int j = 0; j < 4; ++j) { const int n = (lane >> 3) + 8 * j; const LAS float* s = scr + (8 * c) * 33 + n;
        float w[8]; float sb = 0.f;
#pragma unroll
        for (int e = 0; e < 8; ++e) { const float raw = s[e * 33]; sb += bs[e] * raw; w[e] = raw * gs[e]; }
        v4u o; o.x = pk2(w[0], w[1]); o.y = pk2(w[2], w[3]); o.z = pk2(w[4], w[5]); o.w = pk2(w[6], w[7]);
        const int ng = n0 + n;
        const int row = (MAP == 0) ? ng : (MAP == 3) ? ((ng < 512) ? ((ng >> 7) * 256 + (ng & 127)) : (ng < 1024) ? (((ng - 512) >> 7) * 256 + 128 + (ng & 127)) : ng)
                                     : ((ng >> 7) * 256 + (ng & 127) + (MAP == 2 ? 128 : 0));
        *(GAS v4u*)(WT + (size_t)row * K + k0 + 8 * c) = o;
        if (cs) {
            float sc = (bflo(o.x) + bfhi(o.x)) + (bflo(o.y) + bfhi(o.y)) + (bflo(o.z) + bfhi(o.z)) + (bflo(o.w) + bfhi(o.w));
            sc += __shfl_xor(sc, 1); sc += __shfl_xor(sc, 2); sc += __shfl_xor(sc, 4);
            sb += __shfl_xor(sb, 1); sb += __shfl_xor(sb, 2); sb += __shfl_xor(sb, 4);
            if (c == 0) { atomicAdd(cs + row, sc); atomicAdd(bw + row, sb); }
        } }
    LDS_WAIT(); asm volatile("" ::: "memory");
}

struct Args { const float* in[20]; float* out; unsigned char* ws; int ph_lo, ph_hi, flags, pad; };

__device__ __forceinline__ void p0_prologue(const Frame& F, const Args& a) {
    unsigned char* ws = a.ws;
    LAS float* scr = (LAS float*)(F.lds + RING_OFF + F.wave * 16384);
    const int gw = F.vcu * NWAVES + F.wave, NGW = F.G * NWAVES;
    const float* w_in = a.in[2]; const float* w_out = a.in[9]; const float* wg = a.in[12]; const float* wu = a.in[13]; const float* wd = a.in[14]; const float* wpp = a.in[17]; const float* wpg = a.in[18];
    const float* ln1_g = a.in[10]; const float* ln1_b = a.in[11]; const float* ln2_g = a.in[15]; const float* ln2_b = a.in[16];
    float* cs_gu = (float*)(ws + WS_CTL + CTL_CS_GU); float* bw_gu = (float*)(ws + WS_CTL + CTL_BW_GU); float* cs_pg = (float*)(ws + WS_CTL + CTL_CS_PG); float* bw_pg = (float*)(ws + WS_CTL + CTL_BW_PG);
    constexpr int I_IN = (D / 64) * (NIN / 32), I_OUT = (D / 64) * (D / 32), I_G = (D / 64) * (FF / 32), I_DN = (FF / 64) * (D / 32), I_PG = I_OUT, I_PP = (PLE / 64) * (D / 32);
    constexpr int NITEMS = I_IN + I_OUT + 2 * I_G + I_DN + I_PG + I_PP;
    for (int it = gw; it < NITEMS; it += NGW) {
        int r = it;
        if (r < I_IN) { p0_transpose_item<3>(w_in, D, PROJW, NIN / 32, (bf16*)(ws + WS_WIN), nullptr, nullptr, nullptr, nullptr, scr, r, F.lane); continue; } r -= I_IN;
        if (r < I_OUT) { p0_transpose_item<0>(w_out, D, D, D / 32, (bf16*)(ws + WS_WOUT), nullptr, nullptr, nullptr, nullptr, scr, r, F.lane); continue; } r -= I_OUT;
        if (r < I_G) { p0_transpose_item<1>(wg, D, FF, FF / 32, (bf16*)(ws + WS_WGU), ln1_g, ln1_b, cs_gu, bw_gu, scr, r, F.lane); continue; } r -= I_G;
        if (r < I_G) { p0_transpose_item<2>(wu, D, FF, FF / 32, (bf16*)(ws + WS_WGU), ln1_g, ln1_b, cs_gu, bw_gu, scr, r, F.lane); continue; } r -= I_G;
        if (r < I_DN) { p0_transpose_item<0>(wd, FF, D, D / 32, (bf16*)(ws + WS_WDN), nullptr, nullptr, nullptr, nullptr, scr, r, F.lane); continue; } r -= I_DN;
        if (r < I_PG) { p0_transpose_item<0>(wpg, D, D, D / 32, (bf16*)(ws + WS_WPG), ln2_g, ln2_b, cs_pg, bw_pg, scr, r, F.lane); continue; } r -= I_PG;
        p0_transpose_item<0>(wpp, PLE, D, D / 32, (bf16*)(ws + WS_WPP), nullptr, nullptr, nullptr, nullptr, scr, r, F.lane);
    }
    if (gw >= 1 && gw <= 6) { const int v = gw - 1; const float* src = (v == 0) ? ln1_g : (v == 1) ? ln1_b : (v == 2) ? ln2_g : (v == 3) ? ln2_b : (v == 4) ? a.in[19] : a.in[3];
        float* dst = (float*)(ws + WS_CTL + ((v == 0) ? CTL_G1 : (v == 1) ? CTL_B1 : (v == 2) ? CTL_G2 : (v == 3) ? CTL_B2 : (v == 4) ? CTL_BG : CTL_BIAS)); const int len = (v == 5) ? PROJW : D;
        for (int c = 4 * F.lane; c < len; c += 256) *(f32x4*)(dst + c) = *(const f32x4*)(src + c); }
    if (gw == 0) { const float* lg = a.in[4]; float* oml = (float*)(ws + WS_OML);
        for (int c = F.lane; c < 512; c += 64) { const float l0 = lg[c], l1 = lg[512 + c]; const float mx = fmaxf(l0, l1); const float e0 = __expf(l0 - mx), e1 = __expf(l1 - mx); oml[c] = e1 / (e0 + e1); } }
    {
        const float* x = a.in[0]; const float* p = a.in[1]; const float* b_in = a.in[3];
        bf16* XB = (bf16*)(ws + WS_XB); bf16* PB = (bf16*)(ws + WS_PB); float* GATES = (float*)(ws + WS_GATES);
        f32x4 wl[2][8][2];
#pragma unroll
        for (int j = 0; j < 2; ++j)
#pragma unroll
            for (int e = 0; e < 8; ++e) { const float* wp = w_in + (size_t)(8 * F.lane + 512 * j + e) * PROJW + NIN; wl[j][e][0] = *(const f32x4*)wp; wl[j][e][1] = *(const f32x4*)(wp + 4); }
        const float bsel = b_in[NIN + (F.lane >> 3)];
        f32x4 na[2][2], npv;
        { const int m0 = gw < M ? gw : 0; const float* xr = x + (size_t)m0 * D;
#pragma unroll
          for (int j = 0; j < 2; ++j) { na[j][0] = __builtin_nontemporal_load((const f32x4*)(xr + 8 * F.lane + 512 * j)); na[j][1] = __builtin_nontemporal_load((const f32x4*)(xr + 8 * F.lane + 512 * j + 4)); }
          npv = __builtin_nontemporal_load((const f32x4*)(p + (size_t)m0 * PLE + 4 * F.lane)); }
        for (int m = gw; m < M; m += NGW) {
            f32x4 ca[2][2]; const f32x4 pv = npv;
#pragma unroll
            for (int j = 0; j < 2; ++j) { ca[j][0] = na[j][0]; ca[j][1] = na[j][1]; }
            { const int mn = (m + NGW < M) ? (m + NGW) : m; const float* xr = x + (size_t)mn * D;
#pragma unroll
              for (int j = 0; j < 2; ++j) { na[j][0] = __builtin_nontemporal_load((const f32x4*)(xr + 8 * F.lane + 512 * j)); na[j][1] = __builtin_nontemporal_load((const f32x4*)(xr + 8 * F.lane + 512 * j + 4)); }
              npv = __builtin_nontemporal_load((const f32x4*)(p + (size_t)mn * PLE + 4 * F.lane)); }
            f32x4 g0 = {0.f, 0.f, 0.f, 0.f}, g1 = {0.f, 0.f, 0.f, 0.f};
#pragma unroll
            for (int j = 0; j < 2; ++j) { const f32x4 a0 = ca[j][0], a1 = ca[j][1];
                v4u o; o.x = pk2(a0[0], a0[1]); o.y = pk2(a0[2], a0[3]); o.z = pk2(a1[0], a1[1]); o.w = pk2(a1[2], a1[3]);
                *(GAS v4u*)(XB + (size_t)m * D + 8 * F.lane + 512 * j) = o;
#pragma unroll
                for (int e = 0; e < 4; ++e) { g0 += wl[j][e][0] * a0[e]; g1 += wl[j][e][1] * a0[e]; g0 += wl[j][4 + e][0] * a1[e]; g1 += wl[j][4 + e][1] * a1[e]; } }
            const bool b5 = (F.lane & 32) != 0, b4 = (F.lane & 16) != 0, b3 = (F.lane & 8) != 0;
            float k4[4];
#pragma unroll
            for (int e = 0; e < 4; ++e) { const float keep = b5 ? g1[e] : g0[e], send = b5 ? g0[e] : g1[e]; k4[e] = keep + __shfl_xor(send, 32); }
            float k2[2];
#pragma unroll
            for (int e = 0; e < 2; ++e) { const float keep = b4 ? k4[2 + e] : k4[e], send = b4 ? k4[e] : k4[2 + e]; k2[e] = keep + __shfl_xor(send, 16); }
            float k1; { const float keep = b3 ? k2[1] : k2[0], send = b3 ? k2[0] : k2[1]; k1 = keep + __shfl_xor(send, 8); }
            k1 += __shfl_xor(k1, 4); k1 += __shfl_xor(k1, 2); k1 += __shfl_xor(k1, 1);
            if ((F.lane & 7) == 0) GATES[(size_t)m * 8 + (F.lane >> 3)] = k1 + bsel;
            v2u po; po.x = pk2(pv[0], pv[1]); po.y = pk2(pv[2], pv[3]);
            *(GAS v2u*)(PB + (size_t)m * PLE + 4 * F.lane) = po;
        }
    }
}

namespace mx {
typedef short s16x4 __attribute__((ext_vector_type(4)));
typedef short bf16x8 __attribute__((ext_vector_type(8)));
typedef short v4i16_t __attribute__((ext_vector_type(4)));
constexpr int NCH = 8;
constexpr int NSC = SEQ / (64 * NCH);
constexpr int NUNIT = 16 * NSC;
constexpr int L_QT = 0, L_KT = 16384, L_V = 32768, L_G = 49152, L_IMG = 65536  , L_XT = 131072, L_PART = 140288  ;
constexpr int XT_STRIDE = 144;
__device__ __forceinline__ unsigned off_b(unsigned row, unsigned ch) { return 256u * row + 16u * (ch ^ (((row & 3) << 2) | ((row >> 2) & 3))); }
__device__ __forceinline__ unsigned row_addr16(unsigned lane, unsigned rb, unsigned s) { return off_b((lane & 15) + 16 * rb, 4 * s + (lane >> 4)); }
__device__ __forceinline__ unsigned tr_addr16(unsigned lane, unsigned c, unsigned ks, unsigned t) { const unsigned g = lane >> 4, q = (lane & 15) >> 2, p = lane & 3;
    return off_b(32 * ks + 8 * g + 4 * t + q, 2 * c + (p >> 1)) + 8 * (p & 1); }
__device__ __forceinline__ unsigned perm_addr16(unsigned lane, unsigned rb, unsigned ks, unsigned half) { const unsigned g = lane >> 4;
    return off_b((lane & 15) + 16 * rb, 4 * ks + 2 * half + (g >> 1)) + 8 * (g & 1); }
__device__ __forceinline__ bf16x8 ld128(LAS unsigned char* L, unsigned off) { return *(const LAS bf16x8*)(L + off); }
__device__ __forceinline__ s16x4 ld64(LAS unsigned char* L, unsigned off) { return *(const LAS s16x4*)(L + off); }
__device__ __forceinline__ s16x4 ldtr(LAS unsigned char* L, unsigned off) { return __builtin_bit_cast(s16x4, __builtin_amdgcn_ds_read_tr16_b64_v4i16((LAS v4i16_t*)(L + off))); }
using pg8::cvt_pk_bf16;
__device__ __forceinline__ bf16x8 cat(s16x4 lo, s16x4 hi) { return (bf16x8){lo[0], lo[1], lo[2], lo[3], hi[0], hi[1], hi[2], hi[3]}; }
__device__ __forceinline__ bf16x8 pack8(const f32x4& a, const f32x4& b) { v4u w; w.x = cvt_pk_bf16(a[0], a[1]); w.y = cvt_pk_bf16(a[2], a[3]); w.z = cvt_pk_bf16(b[0], b[1]); w.w = cvt_pk_bf16(b[2], b[3]); return __builtin_bit_cast(bf16x8, w); }
#define MX_MFMA(a, b, c) __builtin_amdgcn_mfma_f32_16x16x32_bf16((a), (b), (c), 0, 0, 0)

template <int NKS>
__device__ __forceinline__ void x_tile(LAS unsigned char* L, LAS unsigned char* I, int lane, int sb, int tb) {
    f32x4 x = {0.f, 0.f, 0.f, 0.f};
#pragma unroll
    for (int ks = 0; ks < NKS; ++ks) x = MX_MFMA(ld128(I + L_KT, row_addr16(lane, sb, ks)), ld128(I + L_QT, row_addr16(lane, tb, ks)), x);
    const int g = lane >> 4, l15 = lane & 15;
#ifdef DBG_T5
    x = (f32x4){1.f, 1.f, 1.f, 1.f};
#endif
    if (sb == tb) {
#pragma unroll
        for (int i = 0; i < 4; ++i) x[i] = (4 * g + i <= l15) ? x[i] : 0.f;
    }
    v2u w; w.x = cvt_pk_bf16(x[0], x[1]); w.y = cvt_pk_bf16(x[2], x[3]);
    *(LAS v2u*)(L + L_XT + (16 * tb + l15) * XT_STRIDE + (16 * sb + 4 * g) * 2) = w;
}
template <int NKS>
__device__ __forceinline__ void x_all(LAS unsigned char* L, LAS unsigned char* I, int lane, int w) {
    switch (w) {
        case 0: x_tile<NKS>(L, I, lane, 0, 0); x_tile<NKS>(L, I, lane, 2, 3); break;
        case 1: x_tile<NKS>(L, I, lane, 0, 1); x_tile<NKS>(L, I, lane, 3, 3); break;
        case 2: x_tile<NKS>(L, I, lane, 1, 1); break;
        case 3: x_tile<NKS>(L, I, lane, 0, 2); break;
        case 4: x_tile<NKS>(L, I, lane, 1, 2); break;
        case 5: x_tile<NKS>(L, I, lane, 2, 2); break;
        case 6: x_tile<NKS>(L, I, lane, 0, 3); break;
        default: x_tile<NKS>(L, I, lane, 1, 3); break;
    }
}
__device__ __forceinline__ void x_zero(LAS unsigned char* L, int tid) {
    if (tid < 128) { const int which = tid >> 6, e = tid & 63, t = (which ? 32 : 0) + (e >> 2), s = (which ? 48 : 16) + 4 * (e & 3);
        v2u z; z.x = 0u; z.y = 0u; *(LAS v2u*)(L + L_XT + t * XT_STRIDE + s * 2) = z; }
}
__device__ __forceinline__ void out_store(bf16* orow, const f32x4 (&O)[4], const float (&scale)[4], const f32x4& gn, const v2u (&gw)[4]) {
#pragma unroll
    for (int tb = 0; tb < 4; ++tb) { const float r = scale[tb];
        v2u ww; ww.x = cvt_pk_bf16(O[tb][0] * r * gn[0] * bflo(gw[tb].x), O[tb][1] * r * gn[1] * bfhi(gw[tb].x)); ww.y = cvt_pk_bf16(O[tb][2] * r * gn[2] * bflo(gw[tb].y), O[tb][3] * r * gn[3] * bfhi(gw[tb].y));
        *(GAS v2u*)(orow + (size_t)(16 * tb) * D) = ww; }
}
template <bool NT> __device__ __forceinline__ v4u ldg16(const bf16* p) { return NT ? __builtin_nontemporal_load((const v4u*)p) : *(const GAS v4u*)p; }
#define MX_BAR() do { asm volatile("s_waitcnt lgkmcnt(0)" ::: "memory"); __builtin_amdgcn_s_barrier(); asm volatile("" ::: "memory"); } while (0)
constexpr int L_ERL = 144384;
constexpr int L_CW = 146432;
constexpr int L_GT = 148992;
constexpr int L_DEN = 153344;
constexpr int L_NST = 153856;

template <bool FULL>
__device__ __forceinline__ void hg_unit(const Frame& F, const Args& a, int uid) {
    unsigned char* ws = a.ws; LAS unsigned char* L = F.lds;
    const int tid = F.tid, w = F.wave;
    const int b = uid / (4 * NSC), h = (uid / NSC) & 3, sc = uid % NSC;
    const size_t row0 = (size_t)b * SEQ + (size_t)sc * (64 * NCH);
    const bf16* UQ = (const bf16*)(ws + WS_U + UO_Q) + (size_t)h * M * 128; const bf16* UK = (const bf16*)(ws + WS_U + UO_K) + (size_t)h * M * 128;
    const bf16* UV = (const bf16*)(ws + WS_U + UO_V) + (size_t)h * M * 128; const bf16* UG = (const bf16*)(ws + WS_U + UO_G) + (size_t)h * M * 128; const bf16* EQ = (const bf16*)(ws + WS_LOGF) + (size_t)h * M * 128;
    const float* ER = (const float*)(ws + WS_ER); const float* EL = (const float*)(ws + WS_EL);
    float* SST = (float*)(ws + (FULL ? WS_HGI : WS_HGS)) + (size_t)uid * 16384;
    bf16* OB = (bf16*)a.out;
    const int prow0 = tid >> 4, pch = tid & 15, prow1 = prow0 + 32;
    v4u rk[2], rv[2], rq[2], rg[2]; float rer = 0.f;
#define HG_LOAD(c) do { const size_t rowc_ = row0 + 64 * (c); \
        _Pragma("unroll") for (int i2 = 0; i2 < 2; ++i2) { const size_t eo = (rowc_ + (i2 ? prow1 : prow0)) * 128 + 8 * pch; \
            rk[i2] = ldg16<FULL>(UK + eo); rv[i2] = ldg16<FULL>(UV + eo); \
            if (FULL) { rq[i2] = ldg16<true>(UQ + eo); rg[i2] = ldg16<true>(UG + eo); } } \
        if (tid < 256) rer = ((tid < 128) ? ER : EL)[(rowc_ >> 6) * 512 + h * 128 + (tid & 127)]; } while (0)
    HG_LOAD(0);
    f32x4 S[8];
    { const int lane = F.lane;
#pragma unroll
      for (int db = 0; db < 8; ++db) S[db] = FULL ? __builtin_nontemporal_load((const f32x4*)(SST + ((w * 8 + db) * 64 + lane) * 4)) : (f32x4){0.f, 0.f, 0.f, 0.f}; }
    f32x4 gn = {0.f, 0.f, 0.f, 0.f};
    if (FULL) { gn = *(const f32x4*)(a.in[7] + h * 128 + 16 * w + 4 * (F.lane >> 4)); x_zero(L, tid); }
    asm volatile("" : "+v"(gn));
#define HG_WRITE(P) do { LAS unsigned char* I_ = L + (P) * L_IMG; \
        _Pragma("unroll") for (int i2 = 0; i2 < 2; ++i2) { const unsigned o = off_b(i2 ? prow1 : prow0, pch); \
            *(LAS v4u*)(I_ + L_KT + o) = rk[i2]; *(LAS v4u*)(I_ + L_V + o) = rv[i2]; \
            if (FULL) { *(LAS v4u*)(I_ + L_G + o) = rg[i2]; *(LAS v4u*)(I_ + L_QT + o) = rq[i2]; } } \
        if (tid < 256) *(LAS float*)(L + L_ERL + (P) * 1024 + tid * 4) = rer; } while (0)
    HG_WRITE(0); HG_LOAD(1);
    MX_BAR();
    for (int c = 0; c < NCH; ++c) {
        const size_t rowc = row0 + 64 * c; const int p = c & 1;
        int lane = F.lane; asm volatile("" : "+v"(lane));
        const int g = lane >> 4, l15 = lane & 15;
        LAS unsigned char* I = L + p * L_IMG; LAS unsigned char* E = L + L_ERL + p * 1024;
        if (FULL) x_all<4>(L, I, lane, w);
        __builtin_amdgcn_sched_barrier(0);
        if (c < NCH - 1) { HG_WRITE(p ^ 1); if (c < NCH - 2) HG_LOAD(c + 2); }
        __builtin_amdgcn_sched_barrier(0);
#pragma unroll
        for (int db = 0; db < 8; ++db) S[db] *= *(const LAS f32x4*)(E + (16 * db + 4 * g) * 4);
        s16x4 vlo[2], vhi[2];
#pragma unroll
        for (int ks = 0; ks < 2; ++ks) { vlo[ks] = ldtr(I + L_V, tr_addr16(lane, w, ks, 0)); vhi[ks] = ldtr(I + L_V, tr_addr16(lane, w, ks, 1)); }
        f32x4 O[4];
        if (FULL) {
#pragma unroll
            for (int tb = 0; tb < 4; ++tb) O[tb] = (f32x4){0.f, 0.f, 0.f, 0.f};
#pragma unroll
            for (int ks = 0; ks < 4; ++ks) { const bf16x8 sa = pack8(S[2 * ks], S[2 * ks + 1]);
#pragma unroll
                for (int tb = 0; tb < 4; ++tb) O[tb] = MX_MFMA(sa, cat(ld64(I + L_QT, perm_addr16(lane, tb, ks, 0)), ld64(I + L_QT, perm_addr16(lane, tb, ks, 1))), O[tb]); }
        }
#pragma unroll
        for (int db = 0; db < 8; ++db) {
#pragma unroll
            for (int ks = 0; ks < 2; ++ks) S[db] = MX_MFMA(cat(ldtr(I + L_KT, tr_addr16(lane, db, ks, 0)), ldtr(I + L_KT, tr_addr16(lane, db, ks, 1))), cat(vlo[ks], vhi[ks]), S[db]);
            S[db] *= *(const LAS f32x4*)(E + (128 + 16 * db + 4 * g) * 4); }
        MX_BAR();
        if (FULL) {
            v2u gw[4];
#pragma unroll
            for (int tb = 0; tb < 4; ++tb) gw[tb] = *(const LAS v2u*)(I + L_G + off_b(16 * tb + l15, 2 * w + (g >> 1)) + 8 * (g & 1));
#pragma unroll
            for (int tb = 0; tb < 4; ++tb)
#pragma unroll
                for (int ks = 0; ks < 2; ++ks) if (ks <= (tb >> 1))
                    O[tb] = MX_MFMA(cat(vlo[ks], vhi[ks]), *(const LAS bf16x8*)(L + L_XT + (16 * tb + l15) * XT_STRIDE + (32 * ks + 8 * g) * 2), O[tb]);
#pragma unroll
            for (int tb = 0; tb < 4; ++tb) { float ss = (O[tb][0] * O[tb][0] + O[tb][1] * O[tb][1]) + (O[tb][2] * O[tb][2] + O[tb][3] * O[tb][3]);
                ss += __shfl_xor(ss, 16); ss += __shfl_xor(ss, 32);
                if (g == 0) *(LAS float*)(L + L_PART + (p * 512 + w * 64 + 16 * tb + l15) * 4) = ss; }
            MX_BAR();
            float scale[4];
#pragma unroll
            for (int tb = 0; tb < 4; ++tb) { float tot = 0.f;
#pragma unroll
                for (int ww = 0; ww < 8; ++ww) tot += *(const LAS float*)(L + L_PART + (p * 512 + ww * 64 + 16 * tb + l15) * 4);
                scale[tb] = rsqrtf(tot * (1.0f / 128.0f) + RMS_EPS); }
            out_store(OB + (rowc + l15) * D + h * 128 + 16 * w + 4 * g, O, scale, gn, gw);
        }
    }
#undef HG_WRITE
#undef HG_LOAD
    if (!FULL) {
        const int lane = F.lane;
#pragma unroll
        for (int db = 0; db < 8; ++db) *(f32x4*)(SST + ((w * 8 + db) * 64 + lane) * 4) = S[db];
        if (tid < 128) { float pr = 1.f;
            for (int c = 0; c < NCH; ++c) { const size_t cidx = (row0 >> 6) + c; pr *= ER[cidx * 512 + h * 128 + tid] * EL[cidx * 512 + h * 128 + tid]; }
            ((float*)(ws + WS_ASC))[(size_t)uid * 128 + tid] = pr; }
    }
    MX_BAR();
}

template <bool FULL>
__device__ __forceinline__ void ml_unit(const Frame& F, const Args& a, int uid) {
    unsigned char* ws = a.ws; LAS unsigned char* L = F.lds;
    const int tid = F.tid, w = F.wave;
    const int b = uid / (4 * NSC), h = (uid / NSC) & 3, sc = uid % NSC;
    const size_t row0 = (size_t)b * SEQ + (size_t)sc * (64 * NCH);
    const bf16* MQ = (const bf16*)(ws + WS_U + UO_MQ) + (size_t)h * M * 64; const bf16* MK = (const bf16*)(ws + WS_U + UO_MK) + (size_t)h * M * 64;
    const bf16* MV = (const bf16*)(ws + WS_U + UO_MV) + (size_t)h * M * 128; const bf16* MO = (const bf16*)(ws + WS_U + UO_MO) + (size_t)h * M * 128; const float* GATES = (const float*)(ws + WS_GATES);
    float* SST = (float*)(ws + (FULL ? WS_MLCI : WS_MLC)) + (size_t)uid * 8192;
    float* MLS = (float*)(ws + WS_MLS) + (size_t)uid * 4; float* MLN = (float*)(ws + (FULL ? WS_MLNI : WS_MLN)) + (size_t)uid * 64;
    bf16* OB = (bf16*)a.out;
    LAS float* GT = (LAS float*)(L + L_GT); LAS float* CW = (LAS float*)(L + L_CW); LAS float* DEN = (LAS float*)(L + L_DEN); LAS float* NST = (LAS float*)(L + L_NST);
    const int crow = tid >> 3, cch = tid & 7;
    const int prow0 = tid >> 4, pch = tid & 15, prow1 = prow0 + 32;
    v4u xk[4], xq[4], rv[2], rg[2];
#define ML_LOAD(c) do { const long tseq0_ = (long)sc * (64 * NCH) + 64 * (c) + crow - 3; \
        _Pragma("unroll") for (int k = 0; k < 4; ++k) { const long ts = tseq0_ + k; xk[k] = (v4u){0u, 0u, 0u, 0u}; xq[k] = (v4u){0u, 0u, 0u, 0u}; \
            if (ts >= 0) { const size_t eo = ((size_t)b * SEQ + ts) * 64 + 8 * cch; xk[k] = ldg16<FULL>(MK + eo); if (FULL) xq[k] = ldg16<true>(MQ + eo); } } \
        _Pragma("unroll") for (int i2 = 0; i2 < 2; ++i2) { const size_t eo = (row0 + 64 * (c) + (i2 ? prow1 : prow0)) * 128 + 8 * pch; rv[i2] = ldg16<FULL>(MV + eo); if (FULL) rg[i2] = ldg16<true>(MO + eo); } } while (0)
    ML_LOAD(0);
    f32x4 S[4];
    { const int lane = F.lane;
#pragma unroll
      for (int db = 0; db < 4; ++db) S[db] = FULL ? __builtin_nontemporal_load((const f32x4*)(SST + ((w * 4 + db) * 64 + lane) * 4)) : (f32x4){0.f, 0.f, 0.f, 0.f}; }
    if (tid < 64) NST[tid] = FULL ? MLN[tid] : 0.f;
    if (tid >= 64 && tid < 192) { const int cc = tid - 64; const float* cw = a.in[5]; const float* cb = a.in[6]; const int gc = (cc < 64) ? (h * 64 + cc) : (256 + h * 64 + cc - 64);
#pragma unroll
        for (int k = 0; k < 4; ++k) CW[k * 128 + cc] = cw[k * 512 + gc];
        CW[512 + cc] = cb[gc]; }
    f32x4 gn = {0.f, 0.f, 0.f, 0.f};
    if (FULL) { gn = *(const f32x4*)(a.in[8] + h * 128 + 16 * w + 4 * (F.lane >> 4)); x_zero(L, tid); }
    asm volatile("" : "+v"(gn));
    if (w == 7) { const int lane = F.lane;
        float m_run = FULL ? ((const float*)(ws + WS_MLI))[uid] : -1.0e30f, gsum = 0.f;
        float igv[NCH], fgv[NCH];
#pragma unroll
        for (int c = 0; c < NCH; ++c) { igv[c] = GATES[(row0 + 64 * c + lane) * 8 + h]; fgv[c] = GATES[(row0 + 64 * c + lane) * 8 + 4 + h]; }
#pragma unroll
        for (int c = 0; c < NCH; ++c) {
            const float ig = igv[c], fgp = fgv[c];
            float gc = fminf(fgp, 0.f) - __logf(1.0f + __expf(-fabsf(fgp)));
#define ML_DPPF(x, old, ctrl, rmask, bc) __builtin_bit_cast(float, __builtin_amdgcn_update_dpp(__builtin_bit_cast(int, (old)), __builtin_bit_cast(int, (x)), (ctrl), (rmask), 0xF, (bc)))
            gc += ML_DPPF(gc, 0.f, 0x111, 0xF, true); gc += ML_DPPF(gc, 0.f, 0x112, 0xF, true); gc += ML_DPPF(gc, 0.f, 0x114, 0xF, true); gc += ML_DPPF(gc, 0.f, 0x118, 0xF, true);
            gc += ML_DPPF(gc, 0.f, 0x142, 0xA, false); gc += ML_DPPF(gc, 0.f, 0x143, 0xC, false);
            const float av = ig - gc; float amax = av;
            amax = fmaxf(amax, ML_DPPF(amax, amax, 0x111, 0xF, false)); amax = fmaxf(amax, ML_DPPF(amax, amax, 0x112, 0xF, false)); amax = fmaxf(amax, ML_DPPF(amax, amax, 0x114, 0xF, false)); amax = fmaxf(amax, ML_DPPF(amax, amax, 0x118, 0xF, false));
            amax = fmaxf(amax, ML_DPPF(amax, amax, 0x142, 0xA, false)); amax = fmaxf(amax, ML_DPPF(amax, amax, 0x143, 0xC, false));
            amax = __builtin_bit_cast(float, __builtin_amdgcn_readlane(__builtin_bit_cast(int, amax), 63));
#undef ML_DPPF
            const float mu = fmaxf(m_run, amax);
            GT[c * 128 + lane] = __expf(av - mu); GT[c * 128 + 64 + lane] = __expf(-(gc + mu));
            const float gl = __builtin_bit_cast(float, __builtin_amdgcn_readlane(__builtin_bit_cast(int, gc), 63));
            if (lane == 0) { GT[NCH * 128 + 4 * c] = __expf(m_run - mu); }
            m_run = gl + mu; gsum += gl; }
        if (lane == 0) { GT[NCH * 132] = m_run; GT[NCH * 132 + 1] = gsum; } }
    MX_BAR();
#define ML_WRITE(P, CC) do { LAS unsigned char* I_ = L + (P) * L_IMG; \
        const LAS float* cq = CW + 8 * cch; const LAS float* ck = CW + 64 + 8 * cch; \
        const unsigned o = off_b(crow, cch); \
        { f32x4 kacc0 = *(const LAS f32x4*)(ck + 512), kacc1 = *(const LAS f32x4*)(ck + 516); \
          _Pragma("unroll") for (int k = 0; k < 4; ++k) { const f32x4 wk0 = *(const LAS f32x4*)(ck + 128 * k), wk1 = *(const LAS f32x4*)(ck + 128 * k + 4); \
            kacc0[0] += wk0[0] * bflo(xk[k].x); kacc0[1] += wk0[1] * bfhi(xk[k].x); kacc0[2] += wk0[2] * bflo(xk[k].y); kacc0[3] += wk0[3] * bfhi(xk[k].y); \
            kacc1[0] += wk1[0] * bflo(xk[k].z); kacc1[1] += wk1[1] * bfhi(xk[k].z); kacc1[2] += wk1[2] * bflo(xk[k].w); kacc1[3] += wk1[3] * bfhi(xk[k].w); } \
          const float scl = GT[(CC) * 128 + crow]; \
          _Pragma("unroll") for (int e = 0; e < 4; ++e) { kacc0[e] = fsilu(kacc0[e]) * scl; kacc1[e] = fsilu(kacc1[e]) * scl; } \
          *(LAS bf16x8*)(I_ + L_KT + o) = pack8(kacc0, kacc1); } \
        __builtin_amdgcn_sched_barrier(0); \
        if (FULL) { f32x4 qacc0 = *(const LAS f32x4*)(cq + 512), qacc1 = *(const LAS f32x4*)(cq + 516); \
          _Pragma("unroll") for (int k = 0; k < 4; ++k) { const f32x4 wq0 = *(const LAS f32x4*)(cq + 128 * k), wq1 = *(const LAS f32x4*)(cq + 128 * k + 4); \
            qacc0[0] += wq0[0] * bflo(xq[k].x); qacc0[1] += wq0[1] * bfhi(xq[k].x); qacc0[2] += wq0[2] * bflo(xq[k].y); qacc0[3] += wq0[3] * bfhi(xq[k].y); \
            qacc1[0] += wq1[0] * bflo(xq[k].z); qacc1[1] += wq1[1] * bfhi(xq[k].z); qacc1[2] += wq1[2] * bflo(xq[k].w); qacc1[3] += wq1[3] * bfhi(xq[k].w); } \
          _Pragma("unroll") for (int e = 0; e < 4; ++e) { qacc0[e] = fsilu(qacc0[e]) * 0.125f; qacc1[e] = fsilu(qacc1[e]) * 0.125f; } \
          *(LAS bf16x8*)(I_ + L_QT + o) = pack8(qacc0, qacc1); } \
        __builtin_amdgcn_sched_barrier(0); \
        _Pragma("unroll") for (int i2 = 0; i2 < 2; ++i2) { const unsigned o2 = off_b(i2 ? prow1 : prow0, pch); *(LAS v4u*)(I_ + L_V + o2) = rv[i2]; if (FULL) *(LAS v4u*)(I_ + L_G + o2) = rg[i2]; } } while (0)
    ML_WRITE(0, 0); ML_LOAD(1);
    MX_BAR();
    for (int c = 0; c < NCH; ++c) {
        const size_t rowc = row0 + 64 * c; const int p = c & 1;
        int lane = F.lane; asm volatile("" : "+v"(lane));
        const int g = lane >> 4, l15 = lane & 15;
        LAS unsigned char* I = L + p * L_IMG;
        const float wv = GT[NCH * 128 + 4 * c];
        if (FULL) x_all<2>(L, I, lane, w);
        __builtin_amdgcn_sched_barrier(0);
        if (c < NCH - 1) { ML_WRITE(p ^ 1, c + 1); if (c < NCH - 2) ML_LOAD(c + 2); }
        __builtin_amdgcn_sched_barrier(0);
#pragma unroll
        for (int db = 0; db < 4; ++db) S[db] *= wv;
        s16x4 vlo[2], vhi[2];
#pragma unroll
        for (int ks = 0; ks < 2; ++ks) { vlo[ks] = ldtr(I + L_V, tr_addr16(lane, w, ks, 0)); vhi[ks] = ldtr(I + L_V, tr_addr16(lane, w, ks, 1)); }
        __builtin_amdgcn_sched_barrier(0);
        f32x4 O[4];
        if (FULL) {
#pragma unroll
            for (int tb = 0; tb < 4; ++tb) O[tb] = (f32x4){0.f, 0.f, 0.f, 0.f};
#pragma unroll
            for (int ks = 0; ks < 2; ++ks) { const bf16x8 sa = pack8(S[2 * ks], S[2 * ks + 1]);
#pragma unroll
                for (int tb = 0; tb < 4; ++tb) O[tb] = MX_MFMA(sa, cat(ld64(I + L_QT, perm_addr16(lane, tb, ks, 0)), ld64(I + L_QT, perm_addr16(lane, tb, ks, 1))), O[tb]); }
        }
        __builtin_amdgcn_sched_barrier(0);
#pragma unroll
        for (int db = 0; db < 4; ++db)
#pragma unroll
            for (int ks = 0; ks < 2; ++ks) S[db] = MX_MFMA(cat(ldtr(I + L_KT, tr_addr16(lane, db, ks, 0)), ldtr(I + L_KT, tr_addr16(lane, db, ks, 1))), cat(vlo[ks], vhi[ks]), S[db]);
        __builtin_amdgcn_sched_barrier(0);
        if (w == 1) { const int rg = lane >> 3, ch = lane & 7; float cs[8] = {0.f, 0.f, 0.f, 0.f, 0.f, 0.f, 0.f, 0.f};
#pragma unroll
            for (int r8 = 0; r8 < 8; ++r8) { const v4u kv = *(const LAS v4u*)(I + L_KT + off_b(8 * rg + r8, ch));
                cs[0] += bflo(kv.x); cs[1] += bfhi(kv.x); cs[2] += bflo(kv.y); cs[3] += bfhi(kv.y); cs[4] += bflo(kv.z); cs[5] += bfhi(kv.z); cs[6] += bflo(kv.w); cs[7] += bfhi(kv.w); }
#pragma unroll
            for (int e = 0; e < 8; ++e) { cs[e] += __shfl_xor(cs[e], 8); cs[e] += __shfl_xor(cs[e], 16); cs[e] += __shfl_xor(cs[e], 32); }
            if (lane < 8) {
#pragma unroll
                for (int e = 0; e < 8; ++e) NST[(p ^ 1) * 64 + 8 * lane + e] = wv * NST[p * 64 + 8 * lane + e] + cs[e]; } }
        MX_BAR();
        if (FULL) {
            v2u gw[4];
#pragma unroll
            for (int tb = 0; tb < 4; ++tb) gw[tb] = *(const LAS v2u*)(I + L_G + off_b(16 * tb + l15, 2 * w + (g >> 1)) + 8 * (g & 1));
#pragma unroll
            for (int tb = 0; tb < 4; ++tb)
#pragma unroll
                for (int ks = 0; ks < 2; ++ks) if (ks <= (tb >> 1))
                    O[tb] = MX_MFMA(cat(vlo[ks], vhi[ks]), *(const LAS bf16x8*)(L + L_XT + (16 * tb + l15) * XT_STRIDE + (32 * ks + 8 * g) * 2), O[tb]);
            if (w == 1) { float sx = 0.f, qn = 0.f;
#pragma unroll
                for (int ch = 0; ch < 8; ++ch) { const v4u xv = *(const LAS v4u*)(L + L_XT + lane * XT_STRIDE + 16 * ch);
                    if (ch < 2 * ((lane >> 4) + 1)) sx += (bflo(xv.x) + bfhi(xv.x)) + (bflo(xv.y) + bfhi(xv.y)) + (bflo(xv.z) + bfhi(xv.z)) + (bflo(xv.w) + bfhi(xv.w));
                    const v4u qv = *(const LAS v4u*)(I + L_QT + off_b(lane, ch)); const LAS float* nn = NST + p * 64 + 8 * ch;
                    qn += bflo(qv.x) * nn[0] + bfhi(qv.x) * nn[1] + bflo(qv.y) * nn[2] + bfhi(qv.y) * nn[3] + bflo(qv.z) * nn[4] + bfhi(qv.z) * nn[5] + bflo(qv.w) * nn[6] + bfhi(qv.w) * nn[7]; }
                DEN[p * 64 + lane] = sx + wv * qn; }
#pragma unroll
            for (int tb = 0; tb < 4; ++tb) { float ss = (O[tb][0] * O[tb][0] + O[tb][1] * O[tb][1]) + (O[tb][2] * O[tb][2] + O[tb][3] * O[tb][3]);
                ss += __shfl_xor(ss, 16); ss += __shfl_xor(ss, 32);
                if (g == 0) *(LAS float*)(L + L_PART + (p * 512 + w * 64 + 16 * tb + l15) * 4) = ss; }
            MX_BAR();
            float scale[4];
#pragma unroll
            for (int tb = 0; tb < 4; ++tb) { const int t = 16 * tb + l15; float tot = 0.f;
#pragma unroll
                for (int ww = 0; ww < 8; ++ww) tot += *(const LAS float*)(L + L_PART + (p * 512 + ww * 64 + t) * 4);
                const float dd = fmaxf(fabsf(DEN[p * 64 + t]), GT[c * 128 + 64 + t]);
                scale[tb] = rsqrtf(tot * (1.0f / 128.0f) + RMS_EPS * dd * dd); }
            out_store(OB + (rowc + l15) * D + 512 + h * 128 + 16 * w + 4 * g, O, scale, gn, gw);
        }
    }
#undef ML_WRITE
#undef ML_LOAD
    if (!FULL) {
        const int lane = F.lane;
#pragma unroll
        for (int db = 0; db < 4; ++db) *(f32x4*)(SST + ((w * 4 + db) * 64 + lane) * 4) = S[db];
        if (tid < 64) MLN[tid] = NST[tid];
        if (tid == 0) { MLS[0] = GT[NCH * 132 + 1]; MLS[1] = GT[NCH * 132]; }
    }
    MX_BAR();
}

template <bool FULL>
__device__ __forceinline__ void mixer_pass(const Frame& F, const Args& a) {
    if (F.vcu & 1) {
        for (int u = F.vcu; u < NUNIT; u += F.G) ml_unit<FULL>(F, a, u);
        for (int u = F.vcu; u < NUNIT; u += F.G) hg_unit<FULL>(F, a, u);
    } else {
        for (int u = F.vcu; u < NUNIT; u += F.G) hg_unit<FULL>(F, a, u);
        for (int u = F.vcu; u < NUNIT; u += F.G) ml_unit<FULL>(F, a, u);
    }
}
__device__ __forceinline__ void scan_pass(const Frame& F, const Args& a) {
    unsigned char* ws = a.ws;
    const size_t gt = (size_t)F.vcu * (NWAVES * 64) + F.tid, GT = (size_t)F.G * (NWAVES * 64);
    const float* HGS = (const float*)(ws + WS_HGS); const float* MLSt = (const float*)(ws + WS_MLC);
    float* HGI = (float*)(ws + WS_HGI); float* MLCI = (float*)(ws + WS_MLCI); float* MLNI = (float*)(ws + WS_MLNI); float* MLI = (float*)(ws + WS_MLI);
    const float* ASC = (const float*)(ws + WS_ASC); const float* MLS = (const float*)(ws + WS_MLS); const float* MLN = (const float*)(ws + WS_MLN);
    constexpr size_t N_HG = 16 * 4096, N_MLC = 16 * 2048, N_MLN = 16 * 16;
    for (size_t e0 = gt; e0 < N_HG + N_MLC + N_MLN; e0 += GT) {
        if (e0 < N_HG) { const int bh = (int)(e0 >> 12), e4 = (int)(e0 & 4095); const int d = 16 * ((e4 >> 6) & 7) + 4 * ((e4 & 63) >> 4);
            f32x4 run = {0.f, 0.f, 0.f, 0.f};
            for (int s0 = 0; s0 < NSC; s0 += 16) { f32x4 loc[16], av[16];
#pragma unroll
                for (int k = 0; k < 16; ++k) { const size_t uid = (size_t)bh * NSC + s0 + k; loc[k] = __builtin_nontemporal_load((const f32x4*)(HGS + uid * 16384 + 4 * e4)); av[k] = *(const f32x4*)(ASC + uid * 128 + d); }
#pragma unroll
                for (int k = 0; k < 16; ++k) { const size_t uid = (size_t)bh * NSC + s0 + k; *(f32x4*)(HGI + uid * 16384 + 4 * e4) = run; run = av[k] * run + loc[k]; } }
        } else { const size_t e1 = e0 - N_HG; const bool isn = e1 >= N_MLC; const int bh = isn ? (int)((e1 - N_MLC) >> 4) : (int)(e1 >> 11), e4 = isn ? (int)((e1 - N_MLC) & 15) : (int)(e1 & 2047);
            f32x4 run = {0.f, 0.f, 0.f, 0.f}; float m = 0.f;
            for (int s0 = 0; s0 < NSC; s0 += 16) { f32x4 loc[16]; float Gv[16], mlv[16];
#pragma unroll
                for (int k = 0; k < 16; ++k) { const size_t uid = (size_t)bh * NSC + s0 + k; Gv[k] = MLS[uid * 4]; mlv[k] = MLS[uid * 4 + 1];
                    loc[k] = isn ? *(const f32x4*)(MLN + uid * 64 + 4 * e4) : __builtin_nontemporal_load((const f32x4*)(MLSt + uid * 8192 + 4 * e4)); }
#pragma unroll
                for (int k = 0; k < 16; ++k) { const size_t uid = (size_t)bh * NSC + s0 + k;
                    if (isn) *(f32x4*)(MLNI + uid * 64 + 4 * e4) = run; else *(f32x4*)(MLCI + uid * 8192 + 4 * e4) = run;
                    if (!isn && e4 == 0) MLI[uid] = m;
                    const float mn = fmaxf(m + Gv[k], mlv[k]); run = run * __expf(m + Gv[k] - mn) + loc[k] * __expf(mlv[k] - mn); m = mn; } }
        }
    }
}
}

__global__ void __launch_bounds__(NWAVES * 64, 2) hymba_fwd(Args args) {
    extern __shared__ __attribute__((aligned(16))) unsigned char lds[];
    Frame F;
    F.lds = (LAS unsigned char*)lds;
    F.tid = threadIdx.x; F.lane = F.tid & 63; F.wave = __builtin_amdgcn_readfirstlane(F.tid >> 6);
    F.G = gridDim.x; { const int bx = blockIdx.x; F.vcu = (F.G % 8 == 0) ? (bx % 8) * (F.G / 8) + bx / 8 : bx; }
    unsigned char* ws = args.ws;
    volatile LAS unsigned* MISC = (volatile LAS unsigned*)(F.lds + MISC_OFF);
    for (int u = F.tid; u < (LDS_BYTES - LDSCTL_OFF) / 4; u += NWAVES * 64) ((LAS unsigned*)(F.lds + LDSCTL_OFF))[u] = 0u;
    __syncthreads();
    XcdBarrier bar; bar.bar = (unsigned*)(ws + WS_CTL) + CW_BAR; bar.x = 0; bar.st = nullptr;
    if (N_LAUNCHES == 1) bar = xcd_barrier_post((unsigned*)(ws + WS_CTL) + CW_BAR, MISC + 8);
    const int lo = args.ph_lo, hi = args.ph_hi;
#ifndef PH_MASK
#define PH_MASK 0x1ff
#endif
#define IN(k) (((PH_MASK >> (k)) & 1) && lo <= (k) && (k) < hi)
#define BOTH(k) (IN(k) && IN((k) + 1))
#define GRID_BAR() do { if (N_LAUNCHES == 1) xcd_barrier(bar); } while (0)

    if (IN(0)) { p0_prologue(F, args); if (BOTH(0)) GRID_BAR(); }
    if (IN(1)) {
        pg8::Gemm g{(const bf16*)(ws + WS_XB), (const bf16*)(ws + WS_WIN), M, NIN, D}; pg8::StaticOrder S; S.init(M, NIN, F.G, (int)blockIdx.x);
        EpiInProj E{ws, F.lds + COLV_OFF};
        pg8::gemm_phase<EpiInProj, pg8::StaticOrder, PG8_ALIGN, PG8_SP2>(F.lds + RING_OFF, g, S, E);
        if (BOTH(1)) GRID_BAR();
    }
    if (IN(2)) { mx::mixer_pass<false>(F, args); if (BOTH(2)) GRID_BAR(); }
    if (IN(3)) { mx::scan_pass(F, args);
        if (BOTH(3)) GRID_BAR(); }
    if (IN(4)) { mx::mixer_pass<true>(F, args);
        if (BOTH(4)) GRID_BAR(); }
    if (IN(5)) {
        pg8::Gemm g{(const bf16*)args.out, (const bf16*)(ws + WS_WOUT), M, D, D}; pg8::StaticOrder S; S.init(M, D, F.G, (int)blockIdx.x);
        EpiOutProj E{ws, (args.flags & 1) ? 768u * 1024u : (unsigned)CTL_ST1};
        pg8::gemm_phase<EpiOutProj, pg8::StaticOrder, PG8_ALIGN, PG8_SP2>(F.lds + RING_OFF, g, S, E);
        if (BOTH(5)) GRID_BAR();
    }
    if (IN(6)) {
        pg8::Gemm g{(const bf16*)(ws + WS_LOGF), (const bf16*)(ws + WS_WGU), M, NGU, D}; pg8::StaticOrder S; S.init(M, NGU, F.G, (int)blockIdx.x);
        EpiGateUp E{ws, F.lds + COLV_OFF};
        pg8::gemm_phase<EpiGateUp, pg8::StaticOrder, PG8_ALIGN, PG8_SP2>(F.lds + RING_OFF, g, S, E);
        if (BOTH(6)) GRID_BAR();
    }
    if (IN(7)) {
        pg8::Gemm g{(const bf16*)(ws + WS_U), (const bf16*)(ws + WS_WDN), M, D, FF}; pg8::StaticOrder S; S.init(M, D, F.G, (int)blockIdx.x);
        EpiDown E{ws, F.lds + COLV_OFF};
        pg8::gemm_phase<EpiDown, pg8::StaticOrder, PG8_ALIGN, PG8_SP2>(F.lds + RING_OFF, g, S, E);
    }
    if (IN(8)) {
#ifndef NO_PGEMM
        {   int kp = PLE; asm volatile("" : "+s"(kp));
            pg8::Gemm g{(const bf16*)(ws + WS_PB), (const bf16*)(ws + WS_WPP), M, D, kp}; pg8::StaticOrder S; S.init(M, D, F.G, (int)blockIdx.x);
            EpiPleP E{ws};
            pg8::gemm_phase<EpiPleP, pg8::StaticOrder, PG8_ALIGN, PG8_SP2>(F.lds + RING_OFF, g, S, E); }
#endif
        VM_WAIT(); __syncthreads();
        if (BOTH(7)) GRID_BAR();
#ifndef NO_FGEMM
        {   pg8::Gemm g{(const bf16*)(ws + WS_LOGF), (const bf16*)(ws + WS_WPG), M, D, D}; pg8::StaticOrder S; S.init(M, D, F.G, (int)blockIdx.x);
            EpiFinal E{args.out, ws, F.lds + COLV_OFF};
            pg8::gemm_phase<EpiFinal, pg8::StaticOrder, PG8_ALIGN, PG8_SP2>(F.lds + RING_OFF, g, S, E); }
#endif
    }
#undef IN
#undef BOTH
#undef GRID_BAR
}

extern "C" void kernel_launch(void* const* d_in, const int* in_sizes, int n_in, void* d_out, int out_size, void* d_ws, size_t ws_size, hipStream_t stream) {
    static int grid = 0;
    if (grid == 0) {
        if (n_in != 20 || in_sizes[0] != M * D || out_size != M * D || ws_size < WS_END) { fprintf(stderr, "kernel_launch: unexpected shapes: n_in %d in0 %d out %d ws %zu (need %zu)\n", n_in, n_in > 0 ? in_sizes[0] : -1, out_size, ws_size, (size_t)WS_END); grid = -1; return; }
        int dev = 0, cus = 0, per_cu = 0;
        if (hipGetDevice(&dev) != hipSuccess || hipDeviceGetAttribute(&cus, hipDeviceAttributeMultiprocessorCount, dev) != hipSuccess) { grid = -1; return; }
        if (hipFuncSetAttribute((const void*)hymba_fwd, hipFuncAttributeMaxDynamicSharedMemorySize, LDS_BYTES) != hipSuccess) { fprintf(stderr, "kernel_launch: hipFuncSetAttribute failed\n"); grid = -1; return; }
        if (hipOccupancyMaxActiveBlocksPerMultiprocessor(&per_cu, (const void*)hymba_fwd, NWAVES * 64, LDS_BYTES) != hipSuccess || per_cu < 1)
            fprintf(stderr, "kernel_launch: note: occupancy query reports %d workgroups per CU\n", per_cu);
        (void)hipGetLastError();
        grid = cus;
    }
    if (grid < 0) return;
    if (hipMemsetAsync((char*)d_ws + WS_CTL, 0, CTL_ZERO_BYTES, stream) != hipSuccess) { fprintf(stderr, "kernel_launch: memset failed\n"); return; }
    Args a{};
    for (int i = 0; i < 20; ++i) a.in[i] = (const float*)d_in[i];
    a.out = (float*)d_out; a.ws = (unsigned char*)d_ws;
    if (N_LAUNCHES == 1) { a.ph_lo = 0; a.ph_hi = NPHASE; hipLaunchKernelGGL(hymba_fwd, dim3(grid), dim3(NWAVES * 64), LDS_BYTES, stream, a); }
    else for (int li = 0; li < NPHASE; ++li) { a.ph_lo = li; a.ph_hi = li + 1;
#ifdef PROBE_PHASE
        if (li == PROBE_PHASE) { a.flags = 1; hipLaunchKernelGGL(hymba_fwd, dim3(grid), dim3(NWAVES * 64), LDS_BYTES, stream, a); a.flags = 0; }
#endif
        hipLaunchKernelGGL(hymba_fwd, dim3(grid), dim3(NWAVES * 64), LDS_BYTES, stream, a); }
}
```
